# Optimizing an MI355X kernel written in HIP

```python
import math
import jax, jax.numpy as jnp
from jax import lax
import numpy as np

D_MODEL = 1024
BATCH = 2
SEQ = 8192
DEPTH = 1
DEC_BATCH = 128
DEC_SEQ = 1
PAST_LEN = 2048
PAGE_SIZE = 128

HEAD_DIM_A = 64
N_HEADS_A = 6
D_A = N_HEADS_A * HEAD_DIM_A
D_B = D_MODEL - D_A
N_HEADS_B = 4
HEAD_DIM_B = D_B // N_HEADS_B
DILATED_BRANCHES = ((128, 1), (512, 4), (2048, 16))
WINDOW_MAX = 2048
N_BUCKETS = 32
REL_MAX_DIST = 2048
CONV_W = 4
MLSTM_CHUNK = 128
D_FF = 4 * D_MODEL
N_GATES = 2 * N_HEADS_B
D_IN = 3 * D_A + 2 * D_B + N_GATES
SPLITS = [D_A, 2 * D_A, 3 * D_A, 3 * D_A + D_B, 3 * D_A + 2 * D_B]
EPS = 1e-6
NEG = -1e30

kernel_name = "hybrid_dilated_attn_mlstm_decode_step"


def rmsnorm(x, g):
    xf = x.astype(jnp.float32)
    y = xf * lax.rsqrt(jnp.mean(xf * xf, axis=-1, keepdims=True) + EPS)
    return (y * g.astype(jnp.float32)).astype(x.dtype)


def t5_bucket(dist):
    max_exact = N_BUCKETS // 2
    df = jnp.maximum(dist, 1).astype(jnp.float32)
    large = max_exact + (jnp.log(df / max_exact) / math.log(REL_MAX_DIST / max_exact)
                         * (N_BUCKETS - max_exact)).astype(jnp.int32)
    large = jnp.minimum(large, N_BUCKETS - 1)
    return jnp.where(dist < max_exact, dist, large)


def dilated_prompt(q, k, v, rel_bias, window, dil):
    B, S, H, E = q.shape
    nk = window // dil
    blk = nk
    unit = blk * dil
    s_pad = -(-S // unit) * unit
    nb = s_pad // unit
    padw = ((0, 0), (0, s_pad - S), (0, 0), (0, 0))

    def to_blocks(t):
        return jnp.pad(t, padw).reshape(B, nb, blk, dil, H, E)

    def with_prev(t):
        prev = jnp.pad(t, ((0, 0), (1, 0), (0, 0), (0, 0), (0, 0), (0, 0)))[:, :-1]
        return jnp.concatenate([prev, t], axis=2)

    qb = to_blocks(q)
    kc = with_prev(to_blocks(k))
    vc = with_prev(to_blocks(v))
    qi = jnp.arange(blk)[:, None]
    ki = jnp.arange(2 * blk)[None, :]
    j = qi + blk - ki
    band = (j >= 0) & (j <= nk)
    blk_idx = jnp.arange(nb)[:, None, None]
    mask = band[None] & (blk_idx * blk + ki[None] - blk >= 0)
    bias = rel_bias[t5_bucket(jnp.clip(j, 0, None) * dil)].astype(jnp.float32)
    bias = bias.transpose(2, 0, 1)
    scale = 1.0 / math.sqrt(E)
    s = jnp.einsum('bnqrhe,bnkrhe->bnrhqk', qb, kc).astype(jnp.float32) * scale + bias
    s = jnp.where(mask[None, :, None, None], s, NEG)
    lse = jax.nn.logsumexp(s, axis=-1)
    p = jnp.exp(s - lse[..., None]).astype(v.dtype)
    o = jnp.einsum('bnrhqk,bnkrhe->bnqrhe', p, vc).reshape(B, s_pad, H, E)[:, :S]
    lse = lse.transpose(0, 1, 4, 2, 3).reshape(B, s_pad, H)[:, :S]
    return o, lse


def dilated_step(q, k_all, v_all, rel_bias, window, dil):
    B, T, H, E = q.shape
    P = k_all.shape[1] - T
    nk = window // dil
    j = jnp.arange(nk + 1)
    idx = P + jnp.arange(T)[:, None] - j[None, :] * dil
    valid = idx >= 0
    idx = jnp.maximum(idx, 0)
    kg = k_all[:, idx]
    vg = v_all[:, idx]
    bias = rel_bias[t5_bucket(j * dil)].astype(jnp.float32).T
    scale = 1.0 / math.sqrt(E)
    s = jnp.einsum('bthe,btjhe->bthj', q, kg).astype(jnp.float32) * scale + bias
    s = jnp.where(valid[None, :, None, :], s, NEG)
    lse = jax.nn.logsumexp(s, axis=-1)
    p = jnp.exp(s - lse[..., None]).astype(v_all.dtype)
    o = jnp.einsum('bthj,btjhe->bthe', p, vg)
    return o, lse


def combine_branches(branches):
    o = jnp.stack([b[0] for b in branches])
    lse = jnp.stack([b[1] for b in branches])
    w = jax.nn.softmax(lse, axis=0).astype(o.dtype)
    return jnp.einsum('gbsh,gbshe->bshe', w, o)


def causal_conv(x, buf, w, b):
    S = x.shape[1]
    xp = jnp.concatenate([buf.astype(x.dtype), x], axis=1)
    y = b + sum(xp[:, i:i + S] * w[i] for i in range(CONV_W))
    return y, xp[:, -(CONV_W - 1):]


def mlstm_cell(q, k, v, i_pre, f_pre, C0, n0, m0):
    B, S, H, E = q.shape
    L = min(MLSTM_CHUNK, S)
    s_pad = -(-S // L) * L
    nc = s_pad // L
    pad = s_pad - S
    f32 = jnp.float32

    def chunks4(t):
        t = jnp.pad(t.astype(f32), ((0, 0), (0, pad), (0, 0), (0, 0)))
        return t.reshape(B, nc, L, H, E).transpose(1, 0, 3, 2, 4)

    def chunks3(t, fill):
        t = jnp.pad(t.astype(f32), ((0, 0), (0, pad), (0, 0)), constant_values=fill)
        return t.reshape(B, nc, L, H).transpose(1, 0, 3, 2)

    logf = jax.nn.log_sigmoid(f_pre.astype(f32))
    xs = (chunks4(q), chunks4(k), chunks4(v), chunks3(i_pre, NEG), chunks3(logf, 0.0))
    causal = jnp.tril(jnp.ones((L, L), dtype=bool))

    def step(carry, inp):
        C, n, m = carry
        qc, kc, vc, ic, fc = inp
        a = jnp.cumsum(fc, axis=-1)
        g = a + m[..., None]
        D = jnp.where(causal, a[..., :, None] - a[..., None, :] + ic[..., None, :], NEG)
        m_t = jnp.maximum(g, jnp.max(D, axis=-1))
        w_state = jnp.exp(g - m_t)
        A = jnp.einsum('bhte,bhse->bhts', qc, kc) * jnp.exp(D - m_t[..., None])
        num = (w_state[..., None] * jnp.einsum('bhvk,bhtk->bhtv', C, qc)
               + jnp.einsum('bhts,bhsv->bhtv', A, vc))
        den = w_state * jnp.einsum('bhk,bhtk->bht', n, qc) + jnp.sum(A, axis=-1)
        h = num / jnp.maximum(jnp.abs(den), jnp.exp(-m_t))[..., None]
        b_tot = a[..., -1]
        wl = b_tot[..., None] - a + ic
        m_new = jnp.maximum(b_tot + m, jnp.max(wl, axis=-1))
        wk = jnp.exp(wl - m_new[..., None])
        decay = jnp.exp(b_tot + m - m_new)
        C_new = decay[..., None, None] * C + jnp.einsum('bhs,bhsv,bhsk->bhvk', wk, vc, kc)
        n_new = decay[..., None] * n + jnp.einsum('bhs,bhsk->bhk', wk, kc)
        return (C_new, n_new, m_new), h

    (C, n, m), hs = lax.scan(step, (C0.astype(f32), n0.astype(f32), m0.astype(f32)), xs)
    h = hs.transpose(1, 0, 3, 2, 4).reshape(B, s_pad, H, E)[:, :S]
    return h, C, n, m


def hybrid_layer(x, win_k, win_v, conv_buf, C0, n0, m0, rel_bias,
                 norm1_g, w_in, gate_bias, conv_w, conv_b, wq_head, wk_head,
                 attn_out_g, mh_norm_g, skip, w_out, norm2_g, w_ff1, w_ff2):
    B, S, _ = x.shape
    h = rmsnorm(x, norm1_g)
    z = h @ w_in
    qa, ka, va, xb, ob, gates = jnp.split(z, SPLITS, axis=-1)
    qa = qa.reshape(B, S, N_HEADS_A, HEAD_DIM_A)
    ka = ka.reshape(B, S, N_HEADS_A, HEAD_DIM_A)
    va = va.reshape(B, S, N_HEADS_A, HEAD_DIM_A)

    if win_k is None:
        branches = [dilated_prompt(qa, ka, va, rel_bias, w, d) for (w, d) in DILATED_BRANCHES]
        P = min(WINDOW_MAX, S)
        new_k = ka[:, S - P:]
        new_v = va[:, S - P:]
    else:
        P = win_k.shape[1]
        k_all = jnp.concatenate([win_k.astype(ka.dtype), ka], axis=1)
        v_all = jnp.concatenate([win_v.astype(va.dtype), va], axis=1)
        branches = [dilated_step(qa, k_all, v_all, rel_bias, w, d) for (w, d) in DILATED_BRANCHES]
        new_k = k_all[:, -P:]
        new_v = v_all[:, -P:]
    out_a = rmsnorm(combine_branches(branches).reshape(B, S, D_A), attn_out_g)

    c, new_conv = causal_conv(xb, conv_buf, conv_w, conv_b)
    c_act = jax.nn.silu(c)
    c_h = c_act.reshape(B, S, N_HEADS_B, HEAD_DIM_B)
    qb = jnp.einsum('bshd,hde->bshe', c_h, wq_head)
    kb = jnp.einsum('bshd,hde->bshe', c_h, wk_head) * (1.0 / math.sqrt(HEAD_DIM_B))
    vb = xb.reshape(B, S, N_HEADS_B, HEAD_DIM_B)
    gates = gates + gate_bias
    i_pre, f_pre = gates[..., :N_HEADS_B], gates[..., N_HEADS_B:]
    hb, C, n, m = mlstm_cell(qb, kb, vb, i_pre, f_pre, C0, n0, m0)
    hb = hb * lax.rsqrt(jnp.mean(hb * hb, axis=-1, keepdims=True) + EPS)
    hb = hb.reshape(B, S, D_B) * mh_norm_g.astype(jnp.float32)
    out_b = jax.nn.sigmoid(ob) * (hb.astype(x.dtype) + skip * c_act)

    x = x + jnp.concatenate([out_a, out_b], axis=-1) @ w_out
    h2 = rmsnorm(x, norm2_g)
    x = x + jnp.square(jax.nn.relu(h2 @ w_ff1)) @ w_ff2
    return x, (new_k, new_v, new_conv, C, n, m)


def setup_inputs(seed: int = 0) -> dict:
    key = jax.random.key(seed)
    ks = jax.random.split(key, 32)
    nrm = jax.random.normal
    f32 = jnp.float32
    win_buf = min(WINDOW_MAX, PAST_LEN)
    gate_bias = jnp.concatenate([
        0.1 * nrm(ks[20], (DEPTH, N_HEADS_B), f32),
        jax.random.uniform(ks[21], (DEPTH, N_HEADS_B), f32, 3.0, 6.0)], axis=-1)
    return {
        "x_prompt": nrm(ks[0], (BATCH, SEQ, D_MODEL), f32),
        "x_sample": nrm(ks[1], (DEC_BATCH, DEC_SEQ, D_MODEL), f32),
        "cache_win_k": nrm(ks[2], (DEPTH, DEC_BATCH, win_buf, N_HEADS_A, HEAD_DIM_A), f32),
        "cache_win_v": nrm(ks[3], (DEPTH, DEC_BATCH, win_buf, N_HEADS_A, HEAD_DIM_A), f32),
        "state_conv": nrm(ks[4], (DEPTH, DEC_BATCH, CONV_W - 1, D_B), f32),
        "state_C": 0.1 * nrm(ks[5], (DEPTH, DEC_BATCH, N_HEADS_B, HEAD_DIM_B, HEAD_DIM_B), f32),
        "state_n": 0.5 * nrm(ks[6], (DEPTH, DEC_BATCH, N_HEADS_B, HEAD_DIM_B), f32),
        "state_m": nrm(ks[7], (DEPTH, DEC_BATCH, N_HEADS_B), f32),
        "rel_bias": 0.5 * nrm(ks[8], (N_BUCKETS, N_HEADS_A), f32),
        "norm1_g": 1.0 + 0.02 * nrm(ks[9], (DEPTH, D_MODEL), f32),
        "w_in": nrm(ks[10], (DEPTH, D_MODEL, D_IN), f32) * D_MODEL ** -0.5,
        "gate_bias": gate_bias,
        "conv_w": 0.5 * nrm(ks[11], (DEPTH, CONV_W, D_B), f32),
        "conv_b": 0.02 * nrm(ks[12], (DEPTH, D_B), f32),
        "wq_head": nrm(ks[13], (DEPTH, N_HEADS_B, HEAD_DIM_B, HEAD_DIM_B), f32) * HEAD_DIM_B ** -0.5,
        "wk_head": nrm(ks[14], (DEPTH, N_HEADS_B, HEAD_DIM_B, HEAD_DIM_B), f32) * HEAD_DIM_B ** -0.5,
        "attn_out_g": 1.0 + 0.02 * nrm(ks[15], (DEPTH, D_A), f32),
        "mh_norm_g": 1.0 + 0.02 * nrm(ks[16], (DEPTH, D_B), f32),
        "skip": 1.0 + 0.02 * nrm(ks[17], (DEPTH, D_B), f32),
        "w_out": nrm(ks[18], (DEPTH, D_MODEL, D_MODEL), f32) * D_MODEL ** -0.5,
        "norm2_g": 1.0 + 0.02 * nrm(ks[19], (DEPTH, D_MODEL), f32),
        "w_ff1": nrm(ks[22], (DEPTH, D_MODEL, D_FF), f32) * D_MODEL ** -0.5,
        "w_ff2": nrm(ks[23], (DEPTH, D_FF, D_MODEL), f32) * D_FF ** -0.5,
        "final_g": 1.0 + 0.02 * nrm(ks[24], (D_MODEL,), f32),
    }


def reference(x_prompt, x_sample, cache_win_k, cache_win_v, state_conv, state_C, state_n, state_m,
              rel_bias, norm1_g, w_in, gate_bias, conv_w, conv_b, wq_head, wk_head,
              attn_out_g, mh_norm_g, skip, w_out, norm2_g, w_ff1, w_ff2, final_g):
    xp, xs = x_prompt, x_sample
    Bp = x_prompt.shape[0]
    sts_p, sts_s = [], []
    for l in range(DEPTH):
        lp = (norm1_g[l], w_in[l], gate_bias[l], conv_w[l], conv_b[l], wq_head[l], wk_head[l],
              attn_out_g[l], mh_norm_g[l], skip[l], w_out[l], norm2_g[l], w_ff1[l], w_ff2[l])
        xp, st_p = hybrid_layer(
            xp, None, None,
            jnp.zeros((Bp, CONV_W - 1, D_B), xp.dtype),
            jnp.zeros((Bp, N_HEADS_B, HEAD_DIM_B, HEAD_DIM_B), jnp.float32),
            jnp.zeros((Bp, N_HEADS_B, HEAD_DIM_B), jnp.float32),
            jnp.zeros((Bp, N_HEADS_B), jnp.float32),
            rel_bias, *lp)
        xs, st_s = hybrid_layer(
            xs, cache_win_k[l], cache_win_v[l], state_conv[l], state_C[l], state_n[l], state_m[l],
            rel_bias, *lp)
        sts_p.append(st_p)
        sts_s.append(st_s)
    y_prompt = rmsnorm(xp, final_g)
    y_sample = rmsnorm(xs, final_g)
    p_k = jnp.stack([s[0] for s in sts_p])
    p_v = jnp.stack([s[1] for s in sts_p])
    p_conv = jnp.stack([s[2] for s in sts_p])
    p_C = jnp.stack([s[3] for s in sts_p])
    p_n = jnp.stack([s[4] for s in sts_p])
    p_m = jnp.stack([s[5] for s in sts_p])
    s_k = jnp.stack([s[0] for s in sts_s])
    s_v = jnp.stack([s[1] for s in sts_s])
    s_conv = jnp.stack([s[2] for s in sts_s])
    s_C = jnp.stack([s[3] for s in sts_s])
    s_n = jnp.stack([s[4] for s in sts_s])
    s_m = jnp.stack([s[5] for s in sts_s])
    return (y_prompt, y_sample, p_k, p_v, p_conv, p_C, p_n, p_m, s_k, s_v, s_conv, s_C, s_n, s_m)
```

```cpp
#include <hip/hip_runtime.h>
#include <cstdio>
#include <cstdint>

constexpr int DM = 1024, SEQ = 8192, NBATCH = 2, MP = NBATCH * SEQ, NS = 128, MT = MP + NS, MPAD = 16640;
constexpr int DA = 384, DB = 640, HA = 6, HB = 4, EB = 160, DIN = 2440, ZP = 2560, DFF = 4096;
constexpr int ZQ = 0, ZK = 384, ZV = 768, ZX = 1152, ZO = 1792, ZG = 2432;
constexpr int PAST = 2048, NCH = 64, LCH = 128;
constexpr float EPS = 1e-6f;

namespace pg8 {
#define PG8_LAS __attribute__((address_space(3)))
typedef unsigned short bf16_t;
typedef short bf16x8 __attribute__((ext_vector_type(8)));
typedef float f32x4 __attribute__((ext_vector_type(4)));
typedef unsigned u32x4 __attribute__((ext_vector_type(4)));
constexpr int BM = 256, BK = 64, HALF = 128, HTB = HALF * BK * 2  , STAGE_BYTES = 8 * HTB, NXCD = 8, WGM = 8;

__host__ __device__ __forceinline__ int lds_byte(int r, int c) { const int st = (r >> 4) * 2 + (c >> 5), rr = r & 15, cc = c & 31, ob = rr * 64 + cc * 2; return st * 1024 + (ob ^ (((ob >> 9) & 1) << 5)); }
__host__ __device__ __forceinline__ void stage_rc(int b, int& R, int& C) { const int st = b / 1024, sb = b % 1024, swz = sb ^ (((sb >> 9) & 1) << 5); R = (st >> 1) * 16 + swz / 64; C = (st & 1) * 32 + (swz % 64) / 2; }
__host__ __device__ __forceinline__ int perm32(int rho) { const int n = rho >> 4, i = rho & 15; return 8 * (i >> 2) + 4 * n + (i & 3); }

struct Unit { int pm, pn; };
struct Gemm { const bf16_t* A; const bf16_t* Bt; int M, N, K; };

struct StaticOrder {
    int nM, nN, nwg, G, c;
    __host__ __device__ void init(int M, int N, int G_, int c_) { nM = M / BM; nN = N / BM; nwg = nM * nN; G = G_; c = c_; }
    __host__ __device__ bool next(int i, Unit& u) const {
        const long L = (long)i * G + c; if (L >= nwg) return false;
        int wgid = (int)L; { const int q = nwg / NXCD, r = nwg % NXCD, xcd = wgid % NXCD, off = wgid / NXCD; wgid = (xcd < r ? xcd * (q + 1) : r * (q + 1) + (xcd - r) * q) + off; }
        const int nig = WGM * nN, gid = wgid / nig, fm = gid * WGM, gsz = (nM - fm) < WGM ? (nM - fm) : WGM;
        u.pm = fm + ((wgid % nig) % gsz); u.pn = (wgid % nig) / gsz; return true;
    }
    __device__ __forceinline__ void a_ready(const Unit&) const {}
    __device__ __forceinline__ void done(const Unit&) const {}
};


typedef float f32x2 __attribute__((ext_vector_type(2)));
typedef __bf16 bf16x2_t __attribute__((ext_vector_type(2)));
typedef unsigned u32x2 __attribute__((ext_vector_type(2)));
__device__ __forceinline__ unsigned cvt_pk_bf16(float lo, float hi) { f32x2 v = {lo, hi}; bf16x2_t b = __builtin_convertvector(v, bf16x2_t); return __builtin_bit_cast(unsigned, b); }

struct EpiZ {
    static constexpr bool PERM = true, AFTER_DRAIN = false;
    bf16_t* Z; float* G;
    __device__ __forceinline__ void operator()(const f32x4 (&acc)[2][2][4][2], const Unit& u, int wr, int wc, int fr, int fq) const {
        const int row0 = u.pm * BM + wr * 64 + fr, col0 = u.pn * BM + wc * 32 + 8 * fq;
        const bool gates = (u.pn == 9) && (wc == 0) && (fq == 0);
#pragma unroll
        for (int ai = 0; ai < 2; ++ai)
#pragma unroll
            for (int m = 0; m < 4; ++m) { const int row = row0 + ai * HALF + m * 16; bf16_t* rowp = Z + (size_t)row * 2560 + col0;
#pragma unroll
                for (int bj = 0; bj < 2; ++bj) { const f32x4 v0 = acc[ai][bj][m][0], v1 = acc[ai][bj][m][1];
                    u32x4 w; w.x = cvt_pk_bf16(v0[0], v0[1]); w.y = cvt_pk_bf16(v0[2], v0[3]); w.z = cvt_pk_bf16(v1[0], v1[1]); w.w = cvt_pk_bf16(v1[2], v1[3]);
                    *(u32x4*)(rowp + bj * HALF) = w; }
                if (gates) { *(f32x4*)(G + (size_t)row * 8) = acc[ai][1][m][0]; *(f32x4*)(G + (size_t)row * 8 + 4) = acc[ai][1][m][1]; } }
    }
};
struct EpiX1 {
    static constexpr bool PERM = false, AFTER_DRAIN = false;
    const float* xp; const float* xs; float* X1; bf16_t* X1B; float* SS;
    __device__ __forceinline__ void operator()(const f32x4 (&acc)[2][2][4][2], const Unit& u, int wr, int wc, int fr, int fq) const {
        const int row0 = u.pm * BM + wr * 64 + fr, col0 = u.pn * BM + wc * 32 + 4 * fq;
#pragma unroll
        for (int ai = 0; ai < 2; ++ai)
#pragma unroll
            for (int m = 0; m < 4; ++m) { const int row = row0 + ai * HALF + m * 16;
                const float* xr = row < 16384 ? xp + (size_t)row * 1024 : (row < 16512 ? xs + (size_t)(row - 16384) * 1024 : nullptr);
                float ss = 0.f;
#pragma unroll
                for (int bj = 0; bj < 2; ++bj)
#pragma unroll
                    for (int n = 0; n < 2; ++n) { const int col = col0 + bj * HALF + n * 16;
                        f32x4 xv = {0.f, 0.f, 0.f, 0.f}; if (xr) xv = *(const f32x4*)(xr + col);
                        const f32x4 v = acc[ai][bj][m][n] + xv;
                        *(f32x4*)(X1 + (size_t)row * 1024 + col) = v;
                        u32x2 w; w.x = cvt_pk_bf16(v[0], v[1]); w.y = cvt_pk_bf16(v[2], v[3]); *(u32x2*)(X1B + (size_t)row * 1024 + col) = w;
                        ss += (v[0] * v[0] + v[1] * v[1]) + (v[2] * v[2] + v[3] * v[3]); }
                ss += __shfl_xor(ss, 16); ss += __shfl_xor(ss, 32);
                if (fq == 0) SS[(size_t)row * 16 + u.pn * 4 + wc] = ss; }
    }
};
struct EpiFF1 {
    static constexpr bool PERM = true, AFTER_DRAIN = false;
    bf16_t* H; const float* SS;
    __device__ __forceinline__ void operator()(const f32x4 (&acc)[2][2][4][2], const Unit& u, int wr, int wc, int fr, int fq) const {
        const int row0 = u.pm * BM + wr * 64 + fr, col0 = u.pn * BM + wc * 32 + 8 * fq;
#pragma unroll
        for (int ai = 0; ai < 2; ++ai)
#pragma unroll
            for (int m = 0; m < 4; ++m) { const int row = row0 + ai * HALF + m * 16;
                const f32x4* sp = (const f32x4*)(SS + (size_t)row * 16); const f32x4 s0 = sp[0], s1 = sp[1], s2 = sp[2], s3 = sp[3];
                const float tot = ((s0[0] + s0[1]) + (s0[2] + s0[3])) + ((s1[0] + s1[1]) + (s1[2] + s1[3])) + ((s2[0] + s2[1]) + (s2[2] + s2[3])) + ((s3[0] + s3[1]) + (s3[2] + s3[3]));
                const float rstd = 1.0f / sqrtf(tot * (1.0f / 1024.0f) + 1e-6f);
                bf16_t* rowp = H + (size_t)row * 4096 + col0;
#pragma unroll
                for (int bj = 0; bj < 2; ++bj) { f32x4 v0 = acc[ai][bj][m][0] * rstd, v1 = acc[ai][bj][m][1] * rstd;
#pragma unroll
                    for (int e = 0; e < 4; ++e) { const float a = fmaxf(v0[e], 0.f), b = fmaxf(v1[e], 0.f); v0[e] = a * a; v1[e] = b * b; }
                    u32x4 w; w.x = cvt_pk_bf16(v0[0], v0[1]); w.y = cvt_pk_bf16(v0[2], v0[3]); w.z = cvt_pk_bf16(v1[0], v1[1]); w.w = cvt_pk_bf16(v1[2], v1[3]);
                    *(u32x4*)(rowp + bj * HALF) = w; } }
    }
};
struct EpiX2 {
    static constexpr bool PERM = false, AFTER_DRAIN = false;
    const float* X1; float* yp; float* ys; float* SS;
    __device__ __forceinline__ void operator()(const f32x4 (&acc)[2][2][4][2], const Unit& u, int wr, int wc, int fr, int fq) const {
        const int row0 = u.pm * BM + wr * 64 + fr, col0 = u.pn * BM + wc * 32 + 4 * fq;
#pragma unroll
        for (int ai = 0; ai < 2; ++ai)
#pragma unroll
            for (int m = 0; m < 4; ++m) { const int row = row0 + ai * HALF + m * 16;
                float* orow = row < 16384 ? yp + (size_t)row * 1024 : (row < 16512 ? ys + (size_t)(row - 16384) * 1024 : nullptr);
                float ss = 0.f;
#pragma unroll
                for (int bj = 0; bj < 2; ++bj)
#pragma unroll
                    for (int n = 0; n < 2; ++n) { const int col = col0 + bj * HALF + n * 16;
                        const f32x4 v = acc[ai][bj][m][n] + *(const f32x4*)(X1 + (size_t)row * 1024 + col);
                        if (orow) *(f32x4*)(orow + col) = v;
                        ss += (v[0] * v[0] + v[1] * v[1]) + (v[2] * v[2] + v[3] * v[3]); }
                ss += __shfl_xor(ss, 16); ss += __shfl_xor(ss, 32);
                if (fq == 0) SS[(size_t)row * 16 + u.pn * 4 + wc] = ss; }
    }
};

template <class Epi, class Sched, bool ALIGN_EPI = false, bool SP2 = false>
__device__ __forceinline__ void gemm_phase(PG8_LAS unsigned char* lds, const Gemm g, const Sched& S, const Epi& E) {
    const int tid = threadIdx.x, wid = __builtin_amdgcn_readfirstlane(tid >> 6), lane = tid & 63, wr = wid >> 2, wc = wid & 3, fr = lane & 15, fq = lane >> 4;
    const int K = g.K, nt = K / BK;
    unsigned voffA[2], voffB[2];
#pragma unroll
    for (int i = 0; i < 2; ++i) { int R, C; stage_rc(tid * 16 + i * 8192, R, C); const int Rb = Epi::PERM ? ((R & ~31) + perm32(R & 31)) : R;
        voffA[i] = (unsigned)(R * K + C) * 2u; voffB[i] = (unsigned)(Rb * K + C) * 2u; }
    const size_t kstep = (size_t)(BK * 2);
    const size_t hstep = (size_t)HALF * K * 2;
    const size_t tstep = 2 * hstep;
    const unsigned ldsw = (unsigned)wid * 1024u;
    const int aoff = lds_byte(wr * 64 + fr, fq * 8), boff = lds_byte(wc * 32 + fr, fq * 8);
#define PG8_SA(b, h) (((b) * 2 + (h)) * HTB)
#define PG8_SB(b, h) ((4 + (b) * 2 + (h)) * HTB)
#define PG8_STAGE(bufoff, gbase, voff) do { _Pragma("unroll") for (int _i = 0; _i < 2; ++_i) \
        __builtin_amdgcn_global_load_lds((const unsigned*)((const char*)(gbase) + (voff)[_i]), (PG8_LAS unsigned*)(lds + (bufoff) + ldsw + _i * 8192), 16, 0, 0); } while (0)
#define PG8_LDA(dst, b, h) do { _Pragma("unroll") for (int m = 0; m < 4; ++m) _Pragma("unroll") for (int k = 0; k < 2; ++k) dst[m][k] = *(const PG8_LAS bf16x8*)(lds + PG8_SA(b, h) + aoff + m * 2048 + k * 1024); } while (0)
#define PG8_LDB(dst, b, h) do { _Pragma("unroll") for (int n = 0; n < 2; ++n) _Pragma("unroll") for (int k = 0; k < 2; ++k) dst[n][k] = *(const PG8_LAS bf16x8*)(lds + PG8_SB(b, h) + boff + n * 2048 + k * 1024); } while (0)
#define PG8_MMA(ai, bj, At, Bt) do { __builtin_amdgcn_s_setprio(1); _Pragma("unroll") for (int m = 0; m < 4; ++m) _Pragma("unroll") for (int n = 0; n < 2; ++n) _Pragma("unroll") for (int k = 0; k < 2; ++k) \
        acc[ai][bj][m][n] = __builtin_amdgcn_mfma_f32_16x16x32_bf16(Bt[n][k], At[m][k], acc[ai][bj][m][n], 0, 0, 0); __builtin_amdgcn_s_setprio(0); } while (0)
#define PG8_WAIT_V(n) asm volatile("s_waitcnt vmcnt(" #n ")" ::: "memory")
#define PG8_WAIT_L(n) asm volatile("s_waitcnt lgkmcnt(" #n ")" ::: "memory")
#define PG8_BAR __builtin_amdgcn_s_barrier()
#define PG8_SCHED __builtin_amdgcn_sched_barrier(0)
    Unit cur, nxt; int ui = 0;
    if (!S.next(0, cur)) return;
    f32x4 acc[2][2][4][2];
#pragma unroll
    for (int a = 0; a < 2; ++a)
#pragma unroll
        for (int b = 0; b < 2; ++b)
#pragma unroll
            for (int m = 0; m < 4; ++m)
#pragma unroll
                for (int n = 0; n < 2; ++n) acc[a][b][m][n] = (f32x4){0.f, 0.f, 0.f, 0.f};
    bf16x8 At[4][2], B0[2][2], B1[2][2];
    const char* cA = (const char*)g.A + (size_t)cur.pm * tstep; const char* cB = (const char*)g.Bt + (size_t)cur.pn * tstep;
    S.a_ready(cur);
    if constexpr (SP2) {
        PG8_STAGE(PG8_SB(0, 0), cB, voffB); PG8_STAGE(PG8_SB(0, 1), cB + hstep, voffB); PG8_STAGE(PG8_SA(0, 0), cA, voffA); PG8_STAGE(PG8_SA(0, 1), cA + hstep, voffA);
        if (wr == 1) PG8_BAR;
        PG8_WAIT_V(2); PG8_BAR;
        PG8_STAGE(PG8_SB(1, 0), cB + kstep, voffB); PG8_STAGE(PG8_SA(1, 0), cA + kstep, voffA); PG8_STAGE(PG8_SB(1, 1), cB + hstep + kstep, voffB);
        PG8_WAIT_V(6); PG8_BAR;
    } else {
        PG8_STAGE(PG8_SB(0, 0), cB, voffB); PG8_STAGE(PG8_SA(0, 0), cA, voffA); PG8_STAGE(PG8_SB(0, 1), cB + hstep, voffB); PG8_STAGE(PG8_SA(0, 1), cA + hstep, voffA);
        if (wr == 1) PG8_BAR;
        PG8_WAIT_V(4); PG8_BAR;
        PG8_STAGE(PG8_SB(1, 0), cB + kstep, voffB); PG8_STAGE(PG8_SA(1, 0), cA + kstep, voffA); PG8_STAGE(PG8_SB(1, 1), cB + hstep + kstep, voffB);
        PG8_WAIT_V(6); PG8_BAR;
    }
    for (;;) {
        const bool has_next = S.next(ui + 1, nxt);
        const char* nA = has_next ? (const char*)g.A + (size_t)nxt.pm * tstep : cA; const char* nB = has_next ? (const char*)g.Bt + (size_t)nxt.pn * tstep : cB;
        for (int t = 0; t < nt; t += 2) {
            const bool last = (t == nt - 2);
            const char* a1 = cA + (size_t)(t + 1) * kstep;
            const char* a2 = last ? nA : cA + (size_t)(t + 2) * kstep; const char* b2 = last ? nB : cB + (size_t)(t + 2) * kstep;
            const char* a3 = a2 + kstep; const char* b3 = b2 + kstep;
            if (last && has_next) S.a_ready(nxt);
            if constexpr (SP2) {
            PG8_LDB(B0, 0, 0); PG8_LDB(B1, 0, 1); PG8_SCHED; PG8_LDA(At, 0, 0); PG8_STAGE(PG8_SA(1, 1), a1 + hstep, voffA);
            PG8_WAIT_V(8); PG8_WAIT_L(0); PG8_BAR; PG8_MMA(0, 0, At, B0); PG8_MMA(0, 1, At, B1); PG8_BAR; PG8_SCHED;
            PG8_LDA(At, 0, 1); PG8_STAGE(PG8_SB(0, 0), b2, voffB); PG8_STAGE(PG8_SB(0, 1), b2 + hstep, voffB); PG8_STAGE(PG8_SA(0, 0), a2, voffA);
            PG8_WAIT_V(8); PG8_WAIT_L(0); PG8_BAR; PG8_MMA(1, 0, At, B0); PG8_MMA(1, 1, At, B1); PG8_BAR; PG8_SCHED;
            PG8_LDB(B0, 1, 0); PG8_LDB(B1, 1, 1); PG8_SCHED; PG8_LDA(At, 1, 0); PG8_STAGE(PG8_SA(0, 1), a2 + hstep, voffA);
            PG8_WAIT_V(8); PG8_WAIT_L(0); PG8_BAR; PG8_MMA(0, 0, At, B0); PG8_MMA(0, 1, At, B1); PG8_BAR; PG8_SCHED;
            PG8_LDA(At, 1, 1); PG8_STAGE(PG8_SB(1, 0), b3, voffB); PG8_STAGE(PG8_SB(1, 1), b3 + hstep, voffB); PG8_STAGE(PG8_SA(1, 0), a3, voffA);
            PG8_WAIT_V(8); PG8_WAIT_L(0); PG8_BAR; PG8_MMA(1, 0, At, B0); PG8_MMA(1, 1, At, B1); PG8_BAR; PG8_SCHED;
            } else {
            PG8_LDB(B0, 0, 0); PG8_SCHED; PG8_LDA(At, 0, 0); PG8_STAGE(PG8_SA(1, 1), a1 + hstep, voffA);
            PG8_WAIT_L(8); PG8_BAR; PG8_WAIT_L(0); PG8_MMA(0, 0, At, B0); PG8_BAR; PG8_SCHED;
            PG8_LDB(B1, 0, 1); PG8_STAGE(PG8_SB(0, 0), b2, voffB);
            PG8_BAR; PG8_WAIT_L(0); PG8_MMA(0, 1, At, B1); PG8_BAR;
            PG8_LDA(At, 0, 1); PG8_STAGE(PG8_SA(0, 0), a2, voffA);
            PG8_BAR; PG8_WAIT_L(0); PG8_MMA(1, 0, At, B0); PG8_BAR; PG8_SCHED;
            PG8_STAGE(PG8_SB(0, 1), b2 + hstep, voffB);
            PG8_WAIT_V(6); PG8_BAR; PG8_MMA(1, 1, At, B1); PG8_BAR;
            PG8_LDB(B0, 1, 0); PG8_SCHED; PG8_LDA(At, 1, 0); PG8_STAGE(PG8_SA(0, 1), a2 + hstep, voffA);
            PG8_WAIT_L(8); PG8_BAR; PG8_WAIT_L(0); PG8_MMA(0, 0, At, B0); PG8_BAR; PG8_SCHED;
            PG8_LDB(B1, 1, 1); PG8_STAGE(PG8_SB(1, 0), b3, voffB);
            PG8_BAR; PG8_WAIT_L(0); PG8_MMA(0, 1, At, B1); PG8_BAR;
            PG8_LDA(At, 1, 1); PG8_STAGE(PG8_SA(1, 0), a3, voffA);
            PG8_BAR; PG8_WAIT_L(0); PG8_MMA(1, 0, At, B0); PG8_BAR; PG8_SCHED;
            PG8_STAGE(PG8_SB(1, 1), b3 + hstep, voffB);
            PG8_WAIT_V(6); PG8_BAR; PG8_MMA(1, 1, At, B1); PG8_BAR;
            }
        }
        if constexpr (ALIGN_EPI) { if (wr == 0) PG8_BAR; }
        if constexpr (!Epi::AFTER_DRAIN) { E(acc, cur, wr, wc, fr, fq); S.done(cur); }
        if (!has_next) break;
#pragma unroll
        for (int a = 0; a < 2; ++a)
#pragma unroll
            for (int b = 0; b < 2; ++b)
#pragma unroll
                for (int m = 0; m < 4; ++m)
#pragma unroll
                    for (int n = 0; n < 2; ++n) acc[a][b][m][n] = (f32x4){0.f, 0.f, 0.f, 0.f};
        cur = nxt; cA = nA; cB = nB; ++ui;
        if constexpr (ALIGN_EPI) { if (wr == 1) PG8_BAR; }
    }
    PG8_WAIT_V(0);
    if constexpr (!ALIGN_EPI) { if (wr == 0) PG8_BAR; }
    PG8_BAR;
    if constexpr (Epi::AFTER_DRAIN) { E.fused(acc, cur, wr, wc, fr, fq, lds, wid, lane); S.done(cur); }
#undef PG8_SA
#undef PG8_SB
#undef PG8_STAGE
#undef PG8_LDA
#undef PG8_LDB
#undef PG8_MMA
#undef PG8_WAIT_V
#undef PG8_WAIT_L
#undef PG8_BAR
#undef PG8_SCHED
}
}


#ifndef DUP_ID
#define DUP_ID 0
#endif
#ifndef DUP_N
#define DUP_N 4
#endif
#ifndef STEAL
#define STEAL 1
#endif
#define REP(id) for (int rep_ = 0; rep_ < (DUP_ID == (id) ? 1 + DUP_N : 1); ++rep_)
#ifndef MK_N_LAUNCHES
#define MK_N_LAUNCHES 1
#endif
constexpr int NWAVES = 8;
constexpr int PER_PHASE = 9;
constexpr int N_LAUNCHES = MK_N_LAUNCHES;

constexpr size_t MiB = 1u << 20;
constexpr size_t WS_CTL = 0, CTL_ZERO_BYTES = 1 * MiB;
constexpr size_t WS_WIN = 2 * MiB, WS_WOUT = 7 * MiB, WS_W1 = 9 * MiB, WS_W2 = 17 * MiB, WS_WQ = 25 * MiB, WS_WK = 25 * MiB + 256 * 1024;
constexpr size_t WS_SLAB = 526 * MiB;
constexpr size_t WS_QB = 530 * MiB, WS_KB = 551 * MiB, WS_CAB = 572 * MiB;
constexpr size_t WS_G = 26 * MiB, WS_SS1 = 27 * MiB, WS_SS2 = 29 * MiB, WS_ML = 31 * MiB, WS_BT = 31 * MiB + 4096, WS_MS = 31 * MiB + 8192;
constexpr size_t WS_LSE = 32 * MiB, WS_XN = 34 * MiB, WS_Z = 67 * MiB, WS_AO = 149 * MiB, WS_DC = 185 * MiB, WS_CS = 236 * MiB, WS_CAT = 264 * MiB;
constexpr size_t WS_X1 = 297 * MiB, WS_X1B = 362 * MiB, WS_HFF = 395 * MiB, WS_END = 593 * MiB;
static_assert(WS_XN + (size_t)MPAD * DM * 2 <= WS_Z && WS_Z + (size_t)MPAD * ZP * 2 <= WS_AO && WS_AO + (size_t)3 * MP * DA * 2 <= WS_DC, "ws map 1");
static_assert(WS_DC + (size_t)512 * 161 * 160 * 4 <= WS_CS && WS_CS + (size_t)512 * 176 * 160 * 2 <= WS_CAT && WS_CAT + (size_t)MPAD * DM * 2 <= WS_X1, "ws map 2");
static_assert(WS_X1 + (size_t)MPAD * DM * 4 <= WS_X1B && WS_X1B + (size_t)MPAD * DM * 2 <= WS_HFF && WS_HFF + (size_t)MPAD * DFF * 2 <= WS_SLAB, "ws map 3");
static_assert(WS_SS1 + (size_t)MPAD * 16 * 4 <= WS_SS2 && WS_SS2 + (size_t)MPAD * 16 * 4 <= WS_ML && WS_LSE + (size_t)3 * MP * 6 * 4 <= WS_XN && WS_G + (size_t)MPAD * 8 * 4 <= WS_SS1, "ws map 4");
constexpr int CW_TMO = 0, CW_COPYQ = 64, CW_BAR = 4096;
constexpr unsigned CP_BURST4 = 8192, CP_PER_SLICE = 24, CP_N4 = 2047 * DA / 4, CP_NQ = 2 * NS * CP_PER_SLICE;

constexpr size_t O_YP = 0, O_YS = O_YP + (size_t)MP * DM, O_PWK = O_YS + (size_t)NS * DM, O_PWV = O_PWK + (size_t)NBATCH * 2048 * DA, O_PCONV = O_PWV + (size_t)NBATCH * 2048 * DA;
constexpr size_t O_PC = O_PCONV + (size_t)NBATCH * 3 * DB, O_PN = O_PC + (size_t)NBATCH * HB * EB * EB, O_PM = O_PN + (size_t)NBATCH * HB * EB, O_SWK = O_PM + (size_t)NBATCH * HB;
constexpr size_t O_SWV = O_SWK + (size_t)NS * 2048 * DA, O_SCONV = O_SWV + (size_t)NS * 2048 * DA, O_SC = O_SCONV + (size_t)NS * 3 * DB, O_SN = O_SC + (size_t)NS * HB * EB * EB;
constexpr size_t O_SM = O_SN + (size_t)NS * HB * EB, O_END = O_SM + (size_t)NS * HB;

constexpr int RING_BYTES = 155648;
constexpr int LDSCTL_OFF = RING_BYTES, MISC_OFF = LDSCTL_OFF + 320;
constexpr int LDS_BYTES = RING_BYTES + 512;
static_assert(pg8::STAGE_BYTES <= RING_BYTES, "GEMM stage buffers fit");

#define GAS __attribute__((address_space(1)))
#define LAS __attribute__((address_space(3)))
typedef unsigned short bf16;
typedef unsigned v4u __attribute__((ext_vector_type(4)));
typedef unsigned v2u __attribute__((ext_vector_type(2)));
typedef float f32x4 __attribute__((ext_vector_type(4)));
typedef float f32x16 __attribute__((ext_vector_type(16)));
typedef short bf16x8 __attribute__((ext_vector_type(8)));
typedef short s16x4 __attribute__((ext_vector_type(4)));
typedef short v4i16_t __attribute__((ext_vector_type(4)));
typedef GAS unsigned gu32;
#define RLX_AGENT __ATOMIC_RELAXED, __HIP_MEMORY_SCOPE_AGENT
#define LDS_WAIT() asm volatile("s_waitcnt lgkmcnt(0)" ::: "memory")
#define VM_WAIT() asm volatile("s_waitcnt vmcnt(0)" ::: "memory")
#define CFENCE() asm volatile("" ::: "memory")
__device__ __forceinline__ unsigned pk2(float lo, float hi) { return pg8::cvt_pk_bf16(lo, hi); }
__device__ __forceinline__ float bf2f(unsigned short x) { return __uint_as_float((unsigned)x << 16); }
__device__ __forceinline__ float bflo(unsigned w) { return __uint_as_float(w << 16); }
__device__ __forceinline__ float bfhi(unsigned w) { return __uint_as_float(w & 0xffff0000u); }
__device__ __forceinline__ s16x4 tr_read(const LAS bf16* p) { return __builtin_bit_cast(s16x4, __builtin_amdgcn_ds_read_tr16_b64_v4i16((LAS v4i16_t*)p)); }
__device__ __forceinline__ bf16x8 cat8(s16x4 a, s16x4 b) { return (bf16x8){a[0], a[1], a[2], a[3], b[0], b[1], b[2], b[3]}; }
#define MFMA16(a, b, c) __builtin_amdgcn_mfma_f32_16x16x32_bf16((a), (b), (c), 0, 0, 0)
#define MFMA32(a, b, c) __builtin_amdgcn_mfma_f32_32x32x16_bf16((a), (b), (c), 0, 0, 0)
__device__ __forceinline__ int crow(int r, int hi) { return (r & 3) + 8 * (r >> 2) + 4 * hi; }
__device__ __forceinline__ float wave_sum(float v) {
#pragma unroll
    for (int o = 1; o < 64; o <<= 1) v += __shfl_xor(v, o);
    return v;
}
__device__ __forceinline__ float wave_max(float v) {
#pragma unroll
    for (int o = 1; o < 64; o <<= 1) v = fmaxf(v, __shfl_xor(v, o));
    return v;
}
__device__ __forceinline__ float log_sigmoid(float x) { return -(fmaxf(-x, 0.f) + log1pf(expf(-fabsf(x)))); }
__device__ __forceinline__ float sigmoidf(float x) { return 1.0f / (1.0f + expf(-x)); }
__device__ __forceinline__ float siluf(float x) { return x / (1.0f + expf(-x)); }

#define XB_TMO      128
#define XB_XCNT(j)  (256  + 64 * (j))
#define XB_XSUB(j)  (1280 + 64 * (j))
#define XB_XGEN(j)  (2304 + 64 * (j))
#define XB_TOP      3328
#define XB_TOPGEN   3392
#define XCD_BAR_WORDS 3456
#define XB_SPIN_CAP (1u << 18)

__device__ __forceinline__ unsigned xb_ld(unsigned* p)              { return __hip_atomic_load(p, __ATOMIC_RELAXED, __HIP_MEMORY_SCOPE_AGENT); }
__device__ __forceinline__ unsigned xb_add(unsigned* p, unsigned v) { return __hip_atomic_fetch_add(p, v, __ATOMIC_RELAXED, __HIP_MEMORY_SCOPE_AGENT); }
__device__ __forceinline__ unsigned xb_xcc_id() { return (unsigned)__builtin_amdgcn_s_getreg((3 << 11) | 20) & 0xFu; }
#define XB_SPIN(cond, bar) do { unsigned _sp = 0; while (cond) { __builtin_amdgcn_s_sleep(1); \
    if ((++_sp & 255u) == 0u) { if (xb_ld(&(bar)[XB_TMO])) break; if (_sp > XB_SPIN_CAP) { atomicAdd(&(bar)[XB_TMO], 1u); break; } } } } while (0)

struct XcdBarrier {
    unsigned* bar; unsigned x;
    volatile LAS unsigned* st;
};

__device__ __forceinline__ XcdBarrier xcd_barrier_post(unsigned* bar, volatile LAS unsigned* st) {
    XcdBarrier b; b.bar = bar; b.x = xb_xcc_id(); b.st = st;
    if (threadIdx.x == 0) (void)xb_add(&bar[XB_XCNT(b.x)], 1u);
    return b;
}
__device__ __forceinline__ void xcd_barrier_complete(unsigned* bar, unsigned x, unsigned& nloc, unsigned& nx) {
    const unsigned G = gridDim.x * gridDim.y * gridDim.z;
    unsigned sum, cnt, mine, sp = 0u;
    for (;;) {
        sum = 0u; cnt = 0u; mine = 0u;
#pragma unroll
        for (unsigned j = 0; j < 16; ++j) { const unsigned c = xb_ld(&bar[XB_XCNT(j)]); sum += c; cnt += (c > 0u) ? 1u : 0u; mine = (j == x) ? c : mine; }
        if (sum == G) break;
        __builtin_amdgcn_s_sleep(1);
        if ((++sp & 255u) == 0u) { if (xb_ld(&bar[XB_TMO])) break; if (sp > XB_SPIN_CAP) { atomicAdd(&bar[XB_TMO], 1u); break; } }
    }
    nloc = mine > 0u ? mine : 1u; nx = cnt > 0u ? cnt : 1u;
}

__device__ __forceinline__ void xcd_barrier(const XcdBarrier& b) {
    asm volatile("s_waitcnt vmcnt(0)" ::: "memory");
    __syncthreads();
    if (threadIdx.x == 0) {
        unsigned* bar = b.bar;
        __builtin_amdgcn_s_waitcnt(0);
        unsigned nloc = b.st[0], nx = b.st[1];
        if (nloc == 0u) { xcd_barrier_complete(bar, b.x, nloc, nx); b.st[0] = nloc; b.st[1] = nx; }
        const unsigned old = xb_add(&bar[XB_XSUB(b.x)], 1u);
        const unsigned gen = old / nloc;
        if (old + 1u == (gen + 1u) * nloc) {
            __builtin_amdgcn_fence(__ATOMIC_RELEASE, "agent");
            asm volatile("s_waitcnt vmcnt(0)" ::: "memory");
            const unsigned og = xb_add(&bar[XB_TOP], 1u);
            const unsigned tg = og / nx;
            if (og + 1u == (tg + 1u) * nx) xb_add(&bar[XB_TOPGEN], 1u);
            else XB_SPIN(xb_ld(&bar[XB_TOPGEN]) == tg, bar);
            __builtin_amdgcn_fence(__ATOMIC_ACQUIRE, "agent");
            xb_add(&bar[XB_XGEN(b.x)], 1u);
            asm volatile("s_waitcnt vmcnt(0)" ::: "memory");
        } else {
            XB_SPIN(xb_ld(&bar[XB_XGEN(b.x)]) == gen, bar);
            __builtin_amdgcn_fence(__ATOMIC_ACQUIRE, "agent");
            asm volatile("s_waitcnt vmcnt(0)" ::: "memory");
        }
    }
    __syncthreads();
}


struct Frame {
    LAS unsigned char* lds;
    volatile LAS unsigned* MISC;
    gu32* ctl;
    int tid, lane, wave;
    int vcu, G;
    const float* in[24]; float* out; unsigned char* ws;
    bf16 *WIN, *WOUT, *W1, *W2, *WQ, *WK, *XN, *Z, *AO, *CS, *CAT, *X1B, *HFF, *QB, *KB, *CAB;
    float *Gt, *SS1, *SS2, *ML, *BT, *MS, *LSE, *DC, *X1, *SLAB;
};
enum { I_XP = 0, I_XS, I_CK, I_CV, I_SCONV, I_SC, I_SN, I_SM, I_RELB, I_N1G, I_WIN, I_GB, I_CW, I_CB, I_WQ, I_WK, I_AOG, I_MHG, I_SKIP, I_WOUT, I_N2G, I_W1, I_W2, I_FG };


__device__ __forceinline__ void copy_burst(Frame& F, unsigned q) {
    const unsigned s = q / CP_PER_SLICE, k = q - s * CP_PER_SLICE, tsel = s >> 7, b = s & 127u;
    const f32x4* src = (const f32x4*)((tsel ? F.in[I_CV] : F.in[I_CK]) + (size_t)b * 2048 * DA + DA);
    f32x4* dst = (f32x4*)(F.out + (tsel ? O_SWV : O_SWK) + (size_t)b * 2048 * DA);
    const unsigned i0 = k * CP_BURST4 + (unsigned)F.tid;
    f32x4 v[16];
#pragma unroll
    for (int j = 0; j < 16; ++j) { const unsigned i = i0 + 512u * j; if (i < CP_N4) v[j] = __builtin_nontemporal_load(src + i); }
#pragma unroll
    for (int j = 0; j < 16; ++j) { const unsigned i = i0 + 512u * j; if (i < CP_N4) __builtin_nontemporal_store(v[j], dst + i); }
}
__device__ __forceinline__ void xcd_barrier_steal(const XcdBarrier& b, Frame& F) {
    asm volatile("s_waitcnt vmcnt(0)" ::: "memory");
    __syncthreads();
    volatile LAS unsigned* sw = F.MISC + 12;
    unsigned gen = 0u; bool leader = true;
    if (threadIdx.x == 0) {
        unsigned* bar = b.bar;
        __builtin_amdgcn_s_waitcnt(0);
        unsigned nloc = b.st[0], nx = b.st[1];
        if (nloc == 0u) { xcd_barrier_complete(bar, b.x, nloc, nx); b.st[0] = nloc; b.st[1] = nx; }
        const unsigned old = xb_add(&bar[XB_XSUB(b.x)], 1u);
        gen = old / nloc;
        if (old + 1u == (gen + 1u) * nloc) {
            __builtin_amdgcn_fence(__ATOMIC_RELEASE, "agent");
            asm volatile("s_waitcnt vmcnt(0)" ::: "memory");
            const unsigned og = xb_add(&bar[XB_TOP], 1u);
            const unsigned tg = og / nx;
            if (og + 1u == (tg + 1u) * nx) xb_add(&bar[XB_TOPGEN], 1u);
            else XB_SPIN(xb_ld(&bar[XB_TOPGEN]) == tg, bar);
            __builtin_amdgcn_fence(__ATOMIC_ACQUIRE, "agent");
            xb_add(&bar[XB_XGEN(b.x)], 1u);
            asm volatile("s_waitcnt vmcnt(0)" ::: "memory");
            sw[0] = 0u;
        } else { leader = false; sw[0] = 1u; }
    }
    unsigned iters = 0u;
    for (;;) {
        __syncthreads();
        if (threadIdx.x == 0 && !leader) {
            if (xb_ld(&b.bar[XB_XGEN(b.x)]) != gen || xb_ld(&b.bar[XB_TMO]) != 0u) sw[0] = 0u;
            else { unsigned q = CP_NQ; if (sw[2] == 0u) { q = __hip_atomic_fetch_add((unsigned*)(F.ctl + CW_COPYQ), 1u, __ATOMIC_RELAXED, __HIP_MEMORY_SCOPE_AGENT); if (q >= CP_NQ) sw[2] = 1u; } sw[1] = q;
                   if (++iters > (1u << 22)) { atomicAdd(&b.bar[XB_TMO], 1u); sw[0] = 0u; } }
        }
        __syncthreads();
        if (sw[0] == 0u) break;
        const unsigned q = sw[1];
        if (q < CP_NQ) copy_burst(F, q); else __builtin_amdgcn_s_sleep(8);
    }
    if (threadIdx.x == 0 && !leader) { __builtin_amdgcn_fence(__ATOMIC_ACQUIRE, "agent"); asm volatile("s_waitcnt vmcnt(0)" ::: "memory"); }
    __syncthreads();
}
__device__ __forceinline__ void copy_drain(Frame& F) {
    volatile LAS unsigned* sw = F.MISC + 12;
    for (;;) {
        __syncthreads();
        if (threadIdx.x == 0) { unsigned q = CP_NQ; if (sw[2] == 0u) { q = __hip_atomic_fetch_add((unsigned*)(F.ctl + CW_COPYQ), 2u, __ATOMIC_RELAXED, __HIP_MEMORY_SCOPE_AGENT); if (q >= CP_NQ) sw[2] = 1u; } sw[1] = q; }
        __syncthreads();
        const unsigned q = sw[1];
        if (q >= CP_NQ) break;
        copy_burst(F, q); if (q + 1u < CP_NQ) copy_burst(F, q + 1u);
    }
}

template <int NT, class Epi>
__device__ __forceinline__ void small_gemm(Frame& F, const bf16* A, const bf16* Bt, int K, int kbeg, int kend, int n0, const Epi& E) {
    const int fr = F.lane & 15, fq = F.lane >> 4, r = 16 * F.wave + fr;
    const bf16* ap = A + (size_t)r * K + 8 * fq;
    const bf16* bp = Bt + (size_t)(n0 + fr) * K + 8 * fq;
    f32x4 acc[NT];
#pragma unroll
    for (int nt = 0; nt < NT; ++nt) acc[nt] = (f32x4){0.f, 0.f, 0.f, 0.f};
    bf16x8 a0[4], b0[NT][4], a1[4], b1[NT][4];
#define SG_LOAD(a_, b_, k_) do { _Pragma("unroll") for (int j = 0; j < 4; ++j) { a_[j] = *(const bf16x8*)(ap + (k_) + 32 * j); \
        _Pragma("unroll") for (int nt = 0; nt < NT; ++nt) b_[nt][j] = *(const bf16x8*)(bp + (size_t)nt * 16 * K + (k_) + 32 * j); } } while (0)
#define SG_MMA(a_, b_) do { _Pragma("unroll") for (int j = 0; j < 4; ++j) _Pragma("unroll") for (int nt = 0; nt < NT; ++nt) acc[nt] = MFMA16(b_[nt][j], a_[j], acc[nt]); } while (0)
    SG_LOAD(a0, b0, kbeg);
    for (int k = kbeg; k < kend; k += 256) {
        SG_LOAD(a1, b1, k + 128);
        SG_MMA(a0, b0);
        if (k + 256 < kend) SG_LOAD(a0, b0, k + 256);
        SG_MMA(a1, b1);
    }
#undef SG_LOAD
#undef SG_MMA
    E(acc, r, n0, fq);
}
struct SEpiZ { bf16* Z; float* G;
    __device__ __forceinline__ void operator()(const f32x4 (&acc)[2], int r, int n0, int fq) const {
#pragma unroll
        for (int nt = 0; nt < 2; ++nt) { const int col = n0 + 16 * nt + 4 * fq; v2u w; w.x = pk2(acc[nt][0], acc[nt][1]); w.y = pk2(acc[nt][2], acc[nt][3]);
            *(v2u*)(Z + (size_t)(MP + r) * ZP + col) = w;
            if (col >= ZG && col < ZG + 8) *(f32x4*)(G + (size_t)(MP + r) * 8 + (col - ZG)) = acc[nt]; } } };
struct SEpiX1 { const float* xs; float* X1; bf16* X1B; float* SS;
    __device__ __forceinline__ void operator()(const f32x4 (&acc)[4], int r, int n0, int fq) const {
        float ss = 0.f;
#pragma unroll
        for (int nt = 0; nt < 4; ++nt) { const int col = n0 + 16 * nt + 4 * fq; const f32x4 v = acc[nt] + *(const f32x4*)(xs + (size_t)r * DM + col);
            *(f32x4*)(X1 + (size_t)(MP + r) * DM + col) = v; v2u w; w.x = pk2(v[0], v[1]); w.y = pk2(v[2], v[3]); *(v2u*)(X1B + (size_t)(MP + r) * DM + col) = w;
            ss += (v[0] * v[0] + v[1] * v[1]) + (v[2] * v[2] + v[3] * v[3]); }
        ss += __shfl_xor(ss, 16); ss += __shfl_xor(ss, 32);
        if (fq == 0) SS[(size_t)(MP + r) * 16 + (n0 >> 6)] = ss; } };
struct SEpiFF1 { bf16* H; const float* SS;
    __device__ __forceinline__ void operator()(const f32x4 (&acc)[2], int r, int n0, int fq) const {
        const f32x4* sp = (const f32x4*)(SS + (size_t)(MP + r) * 16); const f32x4 s0 = sp[0], s1 = sp[1], s2 = sp[2], s3 = sp[3];
        const float tot = ((s0[0] + s0[1]) + (s0[2] + s0[3])) + ((s1[0] + s1[1]) + (s1[2] + s1[3])) + ((s2[0] + s2[1]) + (s2[2] + s2[3])) + ((s3[0] + s3[1]) + (s3[2] + s3[3]));
        const float rstd = 1.0f / sqrtf(tot * (1.0f / 1024.0f) + EPS);
#pragma unroll
        for (int nt = 0; nt < 2; ++nt) { const int col = n0 + 16 * nt + 4 * fq; float o[4];
#pragma unroll
            for (int e = 0; e < 4; ++e) { const float a = fmaxf(acc[nt][e] * rstd, 0.f); o[e] = a * a; }
            v2u w; w.x = pk2(o[0], o[1]); w.y = pk2(o[2], o[3]); *(v2u*)(H + (size_t)(MP + r) * DFF + col) = w; } } };
struct SEpiSlab { float* slab;
    __device__ __forceinline__ void operator()(const f32x4 (&acc)[2], int r, int n0, int fq) const {
#pragma unroll
        for (int nt = 0; nt < 2; ++nt) { const int col = n0 + 16 * nt + 4 * fq; *(f32x4*)(slab + (size_t)r * DM + col) = acc[nt]; } } };

__device__ __forceinline__ void p0_transpose_item(const float* W, int K, int N, int Npad, const float* gain, bf16* WT, LAS float* scr, int item, int lane) {
    const int nblk = Npad / 32, kb = item / nblk, nb = item % nblk, k0 = 64 * kb, n0 = 32 * nb;
    const int nn = n0 + (lane & 31);
#pragma unroll
    for (int i = 0; i < 32; ++i) { const int kk = 2 * i + (lane >> 5); float w = nn < N ? W[(size_t)(k0 + kk) * N + nn] : 0.f; if (gain) w *= gain[k0 + kk]; scr[kk * 33 + (lane & 31)] = w; }
    LDS_WAIT(); CFENCE();
    const int c = lane & 7;
#pragma unroll
    for (int j = 0; j < 4; ++j) { const int n = (lane >> 3) + 8 * j; const LAS float* s = scr + (8 * c) * 33 + n;
        v4u o; o.x = pk2(s[0 * 33], s[1 * 33]); o.y = pk2(s[2 * 33], s[3 * 33]); o.z = pk2(s[4 * 33], s[5 * 33]); o.w = pk2(s[6 * 33], s[7 * 33]);
        *(GAS v4u*)(WT + (size_t)(n0 + n) * K + k0 + 8 * c) = o; }
    LDS_WAIT(); CFENCE();
}
__device__ __forceinline__ void p0_prologue(Frame& F) {
    LAS float* scr = (LAS float*)(F.lds + F.wave * 16384);
    const int gw = F.vcu * NWAVES + F.wave, NGW = F.G * NWAVES;
    const int gt = F.vcu * 512 + F.tid, NT = F.G * 512;
    REP(1) {
    constexpr int I_IN = 16 * 80, I_OUT = 16 * 32, I_1 = 16 * 128, I_2 = 64 * 32, NITEMS = I_IN + I_OUT + I_1 + I_2;
    for (int it = gw; it < NITEMS; it += NGW) {
        int r = it;
        if (r < I_IN) { p0_transpose_item(F.in[I_WIN], DM, DIN, ZP, F.in[I_N1G], F.WIN, scr, r, F.lane); continue; } r -= I_IN;
        if (r < I_OUT) { p0_transpose_item(F.in[I_WOUT], DM, DM, DM, nullptr, F.WOUT, scr, r, F.lane); continue; } r -= I_OUT;
        if (r < I_1) { p0_transpose_item(F.in[I_W1], DM, DFF, DFF, F.in[I_N2G], F.W1, scr, r, F.lane); continue; } r -= I_1;
        p0_transpose_item(F.in[I_W2], DFF, DM, DM, nullptr, F.W2, scr, r, F.lane);
    }
    for (int idx = gt; idx < 2 * 102400; idx += NT) { const int mat = idx / 102400, r = idx % 102400, h = r / 25600, e = (r % 25600) / 160, d = r % 160;
        const float s = (mat ? F.in[I_WK] : F.in[I_WQ])[h * 25600 + d * 160 + e] * (mat ? 0.07905694150420949f : 1.0f);
        (mat ? F.WK : F.WQ)[h * 25600 + e * 160 + d] = (bf16)(pk2(s, 0.f) & 0xffffu); }
    for (int m0 = gw; m0 < MT; m0 += 2 * NGW) {
        const int m1 = m0 + NGW; const bool has1 = m1 < MT; const int m1c = has1 ? m1 : m0;
        const float* x0 = m0 < MP ? F.in[I_XP] + (size_t)m0 * DM : F.in[I_XS] + (size_t)(m0 - MP) * DM;
        const float* x1 = m1c < MP ? F.in[I_XP] + (size_t)m1c * DM : F.in[I_XS] + (size_t)(m1c - MP) * DM;
        const GAS f32x4* xr0 = (const GAS f32x4*)x0 + F.lane; const GAS f32x4* xr1 = (const GAS f32x4*)x1 + F.lane;
        f32x4 v[4], u[4]; float s0 = 0.f, s1 = 0.f;
#pragma unroll
        for (int j = 0; j < 4; ++j) { v[j] = xr0[64 * j]; u[j] = xr1[64 * j]; }
#pragma unroll
        for (int j = 0; j < 4; ++j) { s0 += (v[j].x * v[j].x + v[j].y * v[j].y) + (v[j].z * v[j].z + v[j].w * v[j].w); s1 += (u[j].x * u[j].x + u[j].y * u[j].y) + (u[j].z * u[j].z + u[j].w * u[j].w); }
        const float r0 = 1.0f / sqrtf(wave_sum(s0) * (1.f / DM) + EPS), r1 = 1.0f / sqrtf(wave_sum(s1) * (1.f / DM) + EPS);
        GAS unsigned long long* o0 = (GAS unsigned long long*)(F.XN + (size_t)m0 * DM) + F.lane; GAS unsigned long long* o1 = (GAS unsigned long long*)(F.XN + (size_t)m1c * DM) + F.lane;
#pragma unroll
        for (int j = 0; j < 4; ++j) o0[64 * j] = (unsigned long long)pk2(v[j].x * r0, v[j].y * r0) | ((unsigned long long)pk2(v[j].z * r0, v[j].w * r0) << 32);
        if (has1) {
#pragma unroll
            for (int j = 0; j < 4; ++j) o1[64 * j] = (unsigned long long)pk2(u[j].x * r1, u[j].y * r1) | ((unsigned long long)pk2(u[j].z * r1, u[j].w * r1) << 32); }
    }
    for (int idx = gt; idx < NS * 2 * DB; idx += NT) { const int b = idx / (2 * DB), rr = (idx % (2 * DB)) / DB, ch = idx % DB;
        F.out[O_SCONV + (size_t)b * 3 * DB + rr * DB + ch] = F.in[I_SCONV][(size_t)b * 3 * DB + (rr + 1) * DB + ch]; }
    }
}

__device__ __forceinline__ int t5_bucket(int dist) {
    if (dist < 16) return dist;
    const int large = 16 + (int)(logf((float)dist / 16.0f) / 4.852030263919617f * 16.0f);
    return large < 31 ? large : 31;
}
__device__ __forceinline__ void build_bias_table(Frame& F, LAS float* bt) {
    for (int idx = F.tid; idx < 18 * 132; idx += 512) { const int gh = idx / 132, j = idx % 132, g = gh / 6, h = gh % 6;
        bt[idx] = j <= 128 ? F.in[I_RELB][t5_bucket(j << (2 * g)) * 6 + h] : 0.f; }
}
constexpr int VPITCH = 72;
constexpr int P2_BIAS_OFF = 0, P2_VT_OFF = 18 * 132 * 4, P2_VT_WAVE = 32 * VPITCH * 2;
__device__ __forceinline__ void attn_prompt_item(Frame& F, int item, LAS bf16* vl, const LAS float* biasT) {
    const int lane = F.lane, r32 = lane & 31, hi = lane >> 5;
    const int g = item / 3072, rem = item - g * 3072, bh = rem >> 8, tile = rem & 255, b = bh / 6, h = bh - b * 6;
    const int sh = 2 * g, nper = 256 >> sh, r = tile / nper, n = tile & (nper - 1);
    const bf16* Zb = F.Z + (size_t)b * SEQ * ZP;
    const int tq = ((32 * n + r32) << sh) + r;
    bf16x8 qf[4];
    { const bf16* qrow = Zb + (size_t)tq * ZP + ZQ + h * 64 + 8 * hi;
#pragma unroll
      for (int kk = 0; kk < 4; ++kk) qf[kk] = *(const bf16x8*)(qrow + 16 * kk); }
    f32x16 o0, o1;
#pragma unroll
    for (int i = 0; i < 16; ++i) { o0[i] = 0.f; o1[i] = 0.f; }
    float mrun = -1e30f, lrun = 0.f;
    const LAS float* bt = biasT + (g * 6 + h) * 132;
    const LAS bf16* trb = vl + (4 * hi + ((lane & 15) >> 2)) * VPITCH + 16 * ((lane >> 4) & 1) + 4 * (lane & 3);
    const int first = n < 4 ? 4 - n : 0;
    bf16x8 kf[5][4]; v4u vr[5][4];
#pragma unroll
    for (int kt = 0; kt < 5; ++kt) { if (kt >= first) { const int uk0 = 32 * n - 128 + 32 * kt;
        const bf16* krow = Zb + (size_t)(((uk0 + r32) << sh) + r) * ZP + ZK + h * 64 + 8 * hi;
#pragma unroll
        for (int kk = 0; kk < 4; ++kk) kf[kt][kk] = *(const bf16x8*)(krow + 16 * kk);
        const v4u* vrow = (const v4u*)(Zb + (size_t)(((uk0 + (lane >> 1)) << sh) + r) * ZP + ZV + h * 64 + (lane & 1) * 32);
#pragma unroll
        for (int kk = 0; kk < 4; ++kk) vr[kt][kk] = vrow[kk]; } }
#pragma unroll
    for (int kt = 0; kt < 5; ++kt) { if (kt >= first) {
        { LAS v4u* dst = (LAS v4u*)(vl + (lane >> 1) * VPITCH + (lane & 1) * 32); dst[0] = vr[kt][0]; dst[1] = vr[kt][1]; dst[2] = vr[kt][2]; dst[3] = vr[kt][3]; }
        f32x16 st;
#pragma unroll
        for (int i = 0; i < 16; ++i) st[i] = 0.f;
#pragma unroll
        for (int kk = 0; kk < 4; ++kk) st = MFMA32(kf[kt][kk], qf[kk], st);
        const int jb = r32 + 128 - 32 * kt;
        float mt = -1e30f;
#pragma unroll
        for (int i = 0; i < 16; ++i) { const int j = jb - crow(i, hi); const bool ok = (j >= 0) && (j <= 128); const int jc = j < 0 ? 0 : (j > 128 ? 128 : j);
            const float s = ok ? st[i] * 0.125f + bt[jc] : -1e30f; st[i] = s; mt = fmaxf(mt, s); }
        mt = fmaxf(mt, __shfl_xor(mt, 32));
        const float mnew = fmaxf(mrun, mt), alpha = __expf(mrun - mnew);
        float ps = 0.f;
#pragma unroll
        for (int i = 0; i < 16; ++i) { const float p = __expf(st[i] - mnew); st[i] = p; ps += p; }
        ps += __shfl_xor(ps, 32);
        lrun = lrun * alpha + ps; mrun = mnew;
#pragma unroll
        for (int i = 0; i < 16; ++i) { o0[i] *= alpha; o1[i] *= alpha; }
        v4u p0, p1;
        p0.x = pk2(st[0], st[1]); p0.y = pk2(st[2], st[3]); p0.z = pk2(st[4], st[5]); p0.w = pk2(st[6], st[7]);
        p1.x = pk2(st[8], st[9]); p1.y = pk2(st[10], st[11]); p1.z = pk2(st[12], st[13]); p1.w = pk2(st[14], st[15]);
        const bf16x8 pb0 = __builtin_bit_cast(bf16x8, p0), pb1 = __builtin_bit_cast(bf16x8, p1);
        LDS_WAIT(); CFENCE();
        { const bf16x8 a00 = cat8(tr_read(trb), tr_read(trb + 8 * VPITCH));
          const bf16x8 a01 = cat8(tr_read(trb + 16 * VPITCH), tr_read(trb + 24 * VPITCH));
          const bf16x8 a10 = cat8(tr_read(trb + 32), tr_read(trb + 8 * VPITCH + 32));
          const bf16x8 a11 = cat8(tr_read(trb + 16 * VPITCH + 32), tr_read(trb + 24 * VPITCH + 32));
          o0 = MFMA32(a00, pb0, o0); o0 = MFMA32(a01, pb1, o0);
          o1 = MFMA32(a10, pb0, o1); o1 = MFMA32(a11, pb1, o1); }
        LDS_WAIT(); CFENCE();
    } }
    const float inv = 1.0f / lrun, lse = mrun + logf(lrun);
    const size_t orow = (size_t)g * MP + (size_t)b * SEQ + tq;
    bf16* op = F.AO + orow * DA + h * 64 + 4 * hi;
#pragma unroll
    for (int k = 0; k < 4; ++k) { v2u w; w.x = pk2(o0[4 * k] * inv, o0[4 * k + 1] * inv); w.y = pk2(o0[4 * k + 2] * inv, o0[4 * k + 3] * inv); *(v2u*)(op + 8 * k) = w;
                                  v2u w2; w2.x = pk2(o1[4 * k] * inv, o1[4 * k + 1] * inv); w2.y = pk2(o1[4 * k + 2] * inv, o1[4 * k + 3] * inv); *(v2u*)(op + 32 + 8 * k) = w2; }
    if (hi == 0) F.LSE[orow * 6 + h] = lse;
}

__device__ __forceinline__ void attn_sample_item(Frame& F, int b, const LAS float* biasT, LAS float* obuf  ) {
    const int lane = F.lane, sub = lane >> 4, d4 = lane & 15, h = F.wave;
    const bf16* zrow = F.Z + (size_t)(MP + b) * ZP;
    __syncthreads();
    if (h < 6) {
        f32x4 q; { const v2u w = *(const v2u*)(zrow + ZQ + h * 64 + 4 * d4); q = (f32x4){bflo(w.x), bfhi(w.x), bflo(w.y), bfhi(w.y)}; }
        f32x4 kn, vn; { const v2u w = *(const v2u*)(zrow + ZK + h * 64 + 4 * d4); kn = (f32x4){bflo(w.x), bfhi(w.x), bflo(w.y), bfhi(w.y)};
                        const v2u w2 = *(const v2u*)(zrow + ZV + h * 64 + 4 * d4); vn = (f32x4){bflo(w2.x), bfhi(w2.x), bflo(w2.y), bfhi(w2.y)}; }
        if (sub == 0) { *(f32x4*)(F.out + O_SWK + ((size_t)b * 2048 + 2047) * DA + h * 64 + 4 * d4) = kn; *(f32x4*)(F.out + O_SWV + ((size_t)b * 2048 + 2047) * DA + h * 64 + 4 * d4) = vn; }
        const float* ck = F.in[I_CK] + (size_t)b * 2048 * DA + h * 64 + 4 * d4; const float* cv = F.in[I_CV] + (size_t)b * 2048 * DA + h * 64 + 4 * d4;
        float m = -1e30f, l = 0.f; f32x4 o = {0.f, 0.f, 0.f, 0.f};
        for (int it0 = 0; it0 < 97; it0 += 8) {
            f32x4 kb[8], vb[8];
#pragma unroll
            for (int u = 0; u < 8; ++u) { const int idx = 4 * (it0 + u) + sub; const int ic = idx < 387 ? idx : 386; const int g = ic / 129, j = ic - g * 129;
                const int row = j ? 2048 - (j << (2 * g)) : 2047; kb[u] = *(const f32x4*)(ck + (size_t)row * DA); vb[u] = *(const f32x4*)(cv + (size_t)row * DA); }
#pragma unroll
            for (int u = 0; u < 8; ++u) { const int idx = 4 * (it0 + u) + sub; const bool ok = idx < 387; const int ic = ok ? idx : 386; const int g = ic / 129, j = ic - g * 129;
                const f32x4 kk = j ? kb[u] : kn, vv = j ? vb[u] : vn;
                float s = (q[0] * kk[0] + q[1] * kk[1]) + (q[2] * kk[2] + q[3] * kk[3]);
                s += __shfl_xor(s, 1); s += __shfl_xor(s, 2); s += __shfl_xor(s, 4); s += __shfl_xor(s, 8);
                s = ok ? s * 0.125f + biasT[(g * 6 + h) * 132 + j] : -1e30f;
                const float mn = fmaxf(m, s), al = __expf(m - mn), p = ok ? __expf(s - mn) : 0.f;
                l = l * al + p; o = o * al + vv * p; m = mn; }
        }
        float M = fmaxf(m, __shfl_xor(m, 16)); M = fmaxf(M, __shfl_xor(M, 32));
        const float sc = __expf(m - M); l *= sc; o = o * sc;
        l += __shfl_xor(l, 16); l += __shfl_xor(l, 32);
#pragma unroll
        for (int e = 0; e < 4; ++e) { o[e] += __shfl_xor(o[e], 16); o[e] += __shfl_xor(o[e], 32); }
        if (sub == 0) { const float inv = 1.0f / l; *(LAS f32x4*)(obuf + h * 64 + 4 * d4) = o * inv; }
    }
    __syncthreads();
    if (F.tid < 384) {
        float ss = 0.f;
#pragma unroll
        for (int k = 0; k < 6; ++k) { const float v = obuf[k * 64 + lane]; ss += v * v; }
        ss = wave_sum(ss);
        const float rstd = 1.0f / sqrtf(ss * (1.0f / 384.0f) + EPS);
        const int c = F.tid;
        F.CAT[(size_t)(MP + b) * DM + c] = (bf16)(pk2(obuf[c] * rstd * F.in[I_AOG][c], 0.f) & 0xffffu);
    }
}

__device__ __forceinline__ void mlstm_sample_item(Frame& F, int item, LAS float* sb  ) {
    const int b = item >> 2, h = item & 3, tid = F.tid, lane = F.lane;
    LAS float* cact = sb; LAS float* vv = sb + 160; LAS float* qv = sb + 320; LAS float* kv = sb + 480; LAS float* hv = sb + 640; LAS float* red = sb + 800;
    const bf16* zrow = F.Z + (size_t)(MP + b) * ZP;
    __syncthreads();
    if (tid < 160) { const int ch = h * 160 + tid; const float x3 = bf2f(zrow[ZX + ch]);
        const float* sc = F.in[I_SCONV] + (size_t)b * 3 * DB + ch; const float* cw = F.in[I_CW] + ch;
        const float c = F.in[I_CB][ch] + cw[0] * sc[0] + cw[DB] * sc[DB] + cw[2 * DB] * sc[2 * DB] + cw[3 * DB] * x3;
        cact[tid] = siluf(c); vv[tid] = x3; F.out[O_SCONV + (size_t)b * 3 * DB + 2 * DB + ch] = x3; }
    __syncthreads();
    if (tid < 320) { const int e = tid % 160, mat = tid / 160; const v4u* W = (const v4u*)((mat ? F.WK : F.WQ) + (size_t)h * 25600 + e * 160);
        v4u wv[20];
#pragma unroll
        for (int c8 = 0; c8 < 20; ++c8) wv[c8] = W[c8];
        float s = 0.f;
#pragma unroll
        for (int c8 = 0; c8 < 20; ++c8) { const LAS float* ca = cact + 8 * c8;
            s += (ca[0] * bflo(wv[c8].x) + ca[1] * bfhi(wv[c8].x)) + (ca[2] * bflo(wv[c8].y) + ca[3] * bfhi(wv[c8].y)) + (ca[4] * bflo(wv[c8].z) + ca[5] * bfhi(wv[c8].z)) + (ca[6] * bflo(wv[c8].w) + ca[7] * bfhi(wv[c8].w)); }
        if (mat) kv[e] = s; else qv[e] = s; }
    __syncthreads();
    const float gi = F.Gt[(size_t)(MP + b) * 8 + h] + F.in[I_GB][h], gf = F.Gt[(size_t)(MP + b) * 8 + 4 + h] + F.in[I_GB][4 + h];
    const float a = log_sigmoid(gf), m0 = F.in[I_SM][b * 4 + h];
    const float mt = fmaxf(a + m0, gi), wst = expf(a + m0 - mt), wkk = expf(gi - mt);
    const float* nst = F.in[I_SN] + (size_t)(b * 4 + h) * 160;
    float qk = 0.f, nq = 0.f;
    for (int e = lane; e < 160; e += 64) { qk += qv[e] * kv[e]; nq += nst[e] * qv[e]; }
    qk = wave_sum(qk); nq = wave_sum(nq);
    const float A = qk * wkk, den = wst * nq + A, denom = fmaxf(fabsf(den), expf(-mt));
    const float* Cst = F.in[I_SC] + (size_t)(b * 4 + h) * 25600; float* Cout = F.out + O_SC + (size_t)(b * 4 + h) * 25600;
    {
        const int gl = lane >> 3, jl = lane & 7;
        f32x4 c4[3][5];
#pragma unroll
        for (int p = 0; p < 3; ++p) { const int rl = p * 8 + gl; const bool ok = rl < 20; const int v = F.wave * 20 + (ok ? rl : 0);
#pragma unroll
            for (int i = 0; i < 5; ++i) c4[p][i] = __builtin_nontemporal_load((const f32x4*)(Cst + v * 160) + jl + 8 * i); }
#pragma unroll
        for (int p = 0; p < 3; ++p) { const int rl = p * 8 + gl; const bool ok = rl < 20; const int v = F.wave * 20 + (ok ? rl : 0);
            const float wv = wkk * vv[v]; float dot = 0.f;
#pragma unroll
            for (int i = 0; i < 5; ++i) { const f32x4 q4 = *(const LAS f32x4*)(qv + 4 * (jl + 8 * i)), k4 = *(const LAS f32x4*)(kv + 4 * (jl + 8 * i));
                dot += (c4[p][i][0] * q4[0] + c4[p][i][1] * q4[1]) + (c4[p][i][2] * q4[2] + c4[p][i][3] * q4[3]);
                const f32x4 cn = c4[p][i] * wst + k4 * wv;
                if (ok) __builtin_nontemporal_store(cn, (f32x4*)(Cout + v * 160) + jl + 8 * i); }
            dot += __shfl_xor(dot, 1); dot += __shfl_xor(dot, 2); dot += __shfl_xor(dot, 4);
            if (ok && jl == 0) hv[v] = (wst * dot + A * vv[v]) / denom; }
    }
    __syncthreads();
    if (tid < 160) F.out[O_SN + (size_t)(b * 4 + h) * 160 + tid] = wst * nst[tid] + wkk * kv[tid];
    if (tid == 0) F.out[O_SM + b * 4 + h] = mt;
    float ss = 0.f;
    for (int e = lane; e < 160; e += 64) ss += hv[e] * hv[e];
    ss = wave_sum(ss);
    const float rs = 1.0f / sqrtf(ss * (1.0f / 160.0f) + EPS);
    if (tid < 160) { const int ch = h * 160 + tid; const float hb = hv[tid] * rs * F.in[I_MHG][ch]; const float ob = bf2f(zrow[ZO + ch]);
        const float o = sigmoidf(ob) * (hb + F.in[I_SKIP][ch] * cact[tid]);
        F.CAT[(size_t)(MP + b) * DM + DA + ch] = (bf16)(pk2(o, 0.f) & 0xffffu); }
}

constexpr int CAP = 168, VTP = 176;
constexpr int ML_CA = 0, ML_KS = 128 * CAP * 2, ML_VT = 2 * 128 * CAP * 2, ML_GA = ML_VT + 128 * VTP * 2;
constexpr int MC_VT = 0, MC_GA = 128 * VTP * 2;
static_assert(ML_GA + 4096 <= RING_BYTES, "mlstm LDS");
__device__ __forceinline__ void mlstm_vt_ones(Frame& F, LAS bf16* VT) {
    for (int idx = F.tid; idx < 256; idx += 512) { const int t = idx >> 1, part = idx & 1;
        *(LAS v4u*)(VT + t * VTP + 160 + part * 8) = part ? (v4u){0u, 0u, 0u, 0u} : (v4u){0x3F80u, 0u, 0u, 0u}; }
}
__device__ __forceinline__ void mlstm_stageA_item(Frame& F, int item) {
    int lane = F.lane; asm volatile("" : "+v"(lane));
    const int bh = item >> 6, c = item & 63, b = bh >> 2, h = bh & 3, fr = lane & 15, fq = lane >> 4, tid = lane + 64 * F.wave;
    const size_t row0 = (size_t)b * SEQ + (size_t)c * 128;
    LAS bf16* CA = (LAS bf16*)(F.lds + ML_CA); LAS bf16* KS = (LAS bf16*)(F.lds + ML_KS); LAS bf16* VT = (LAS bf16*)(F.lds + ML_VT); LAS float* GA = (LAS float*)(F.lds + ML_GA);
    __syncthreads();
    if (F.wave == 0) {
        const float gb_i = F.in[I_GB][h], gb_f = F.in[I_GB][4 + h];
        const float* g0 = F.Gt + (row0 + 2 * lane) * 8;
        const float gi0 = g0[h] + gb_i, gf0 = g0[4 + h] + gb_f, gi1 = g0[8 + h] + gb_i, gf1 = g0[12 + h] + gb_f;
        const float lf0 = log_sigmoid(gf0), lf1 = log_sigmoid(gf1), pair = lf0 + lf1;
        float incl = pair;
#pragma unroll
        for (int o = 1; o < 64; o <<= 1) { const float t = __shfl_up(incl, o); if (lane >= o) incl += t; }
        const float a0 = (incl - pair) + lf0, a1 = incl;
        const float btot = __shfl(incl, 63);
        const float wl0 = btot - a0 + gi0, wl1 = btot - a1 + gi1;
        const float ml = wave_max(fmaxf(wl0, wl1));
        GA[2 * lane] = expf(wl0 - ml); GA[2 * lane + 1] = expf(wl1 - ml);
        if (lane == 0) { F.ML[item] = ml; F.BT[item] = btot; }
    }
    if (tid < 440) {
        const int cg = tid % 20, tg = tid / 20, t0 = 6 * tg, ch0 = h * 160 + cg * 8;
        const bf16* Zb = F.Z + (size_t)b * SEQ * ZP + ZX + ch0;
        v4u xr[9];
#pragma unroll
        for (int k = 0; k < 9; ++k) { const int tl = t0 - 3 + k, tk = c * 128 + tl; xr[k] = (tk >= 0 && tl < 128) ? *(const v4u*)(Zb + (size_t)tk * ZP) : (v4u){0u, 0u, 0u, 0u}; }
        f32x4 wa[4], wb[4];
#pragma unroll
        for (int k = 0; k < 4; ++k) { wa[k] = *(const f32x4*)(F.in[I_CW] + k * DB + ch0); wb[k] = *(const f32x4*)(F.in[I_CW] + k * DB + ch0 + 4); }
        const f32x4 ba = *(const f32x4*)(F.in[I_CB] + ch0), bb = *(const f32x4*)(F.in[I_CB] + ch0 + 4);
#pragma unroll
        for (int i = 0; i < 6; ++i) { const int t = t0 + i; if (t < 128) {
            f32x4 ya = ba, yb = bb;
#pragma unroll
            for (int k = 0; k < 4; ++k) { const v4u x = xr[i + k];
                ya[0] += wa[k][0] * bflo(x.x); ya[1] += wa[k][1] * bfhi(x.x); ya[2] += wa[k][2] * bflo(x.y); ya[3] += wa[k][3] * bfhi(x.y);
                yb[0] += wb[k][0] * bflo(x.z); yb[1] += wb[k][1] * bfhi(x.z); yb[2] += wb[k][2] * bflo(x.w); yb[3] += wb[k][3] * bfhi(x.w); }
            v4u o; o.x = pk2(siluf(ya[0]), siluf(ya[1])); o.y = pk2(siluf(ya[2]), siluf(ya[3])); o.z = pk2(siluf(yb[0]), siluf(yb[1])); o.w = pk2(siluf(yb[2]), siluf(yb[3]));
            *(LAS v4u*)(CA + t * CAP + cg * 8) = o;
            *(v4u*)(F.CAB + (row0 + t) * DB + ch0) = o;
            *(LAS v4u*)(VT + t * VTP + cg * 8) = xr[i + 3]; } }
    }
    mlstm_vt_ones(F, VT);
    __syncthreads();
    {
        const int ntile = F.wave < 4 ? 3 : 2;
        bf16x8 wf[3][5];
#pragma unroll
        for (int j = 0; j < 3; ++j) { const int ti = F.wave + 8 * (j < ntile ? j : 0); const bf16* wb_ = (ti >= 10 ? F.WK : F.WQ) + (size_t)h * 25600 + (size_t)((ti % 10) * 16 + fr) * 160 + 8 * fq;
#pragma unroll
            for (int kk = 0; kk < 5; ++kk) wf[j][kk] = *(const bf16x8*)(wb_ + 32 * kk); }
#pragma unroll
        for (int j = 0; j < 3; ++j) { if (j < ntile) { const int ti = F.wave + 8 * j; const bool isk = ti >= 10; const int e0 = (ti % 10) * 16 + 4 * fq;
            for (int tt = 0; tt < 8; ++tt) { const int t = 16 * tt + fr;
                f32x4 acc = {0.f, 0.f, 0.f, 0.f};
#pragma unroll
                for (int kk = 0; kk < 5; ++kk) acc = MFMA16(wf[j][kk], *(const LAS bf16x8*)(CA + t * CAP + 32 * kk + 8 * fq), acc);
                v2u w; w.x = pk2(acc[0], acc[1]); w.y = pk2(acc[2], acc[3]);
                if (!isk) *(v2u*)(F.QB + (row0 + t) * DB + h * 160 + e0) = w;
                else { *(v2u*)(F.KB + (row0 + t) * DB + h * 160 + e0) = w; const float wk = GA[t];
                       v2u ws; ws.x = pk2(acc[0] * wk, acc[1] * wk); ws.y = pk2(acc[2] * wk, acc[3] * wk); *(LAS v2u*)(KS + t * CAP + e0) = ws; } } } }
    }
    __syncthreads();
    for (int tix = F.wave; tix < 110; tix += 8) { const int vt = tix / 10, et = tix - vt * 10;
        f32x4 acc = {0.f, 0.f, 0.f, 0.f};
        const LAS bf16* ap = VT + (8 * fq + (fr >> 2)) * VTP + vt * 16 + 4 * (fr & 3);
        const LAS bf16* bp = KS + (8 * fq + (fr >> 2)) * CAP + et * 16 + 4 * (fr & 3);
#pragma unroll
        for (int ks = 0; ks < 4; ++ks) { const bf16x8 a = cat8(tr_read(ap + 32 * ks * VTP), tr_read(ap + (32 * ks + 4) * VTP));
                                         const bf16x8 bq = cat8(tr_read(bp + 32 * ks * CAP), tr_read(bp + (32 * ks + 4) * CAP)); acc = MFMA16(a, bq, acc); }
        float* dp = F.DC + ((size_t)item * 161 + vt * 16 + 4 * fq) * 160 + et * 16 + fr;
#pragma unroll
        for (int r = 0; r < 4; ++r) if (vt * 16 + 4 * fq + r <= 160) dp[r * 160] = acc[r];
    }
}
__device__ __forceinline__ void mlstm_scan(Frame& F) {
    LAS float* SA = (LAS float*)F.lds; LAS float* SB = SA + 512; LAS float* SM = SA + 1024;
    __syncthreads();
    for (int idx = F.tid; idx < 512; idx += 512) { SA[idx] = F.BT[idx]; SB[idx] = F.ML[idx]; }
    __syncthreads();
    if (F.tid < 8) { const int chain = F.tid; float m = 0.f;
        for (int c = 0; c < 64; ++c) { const float bt = SA[chain * 64 + c], ml = SB[chain * 64 + c], mn = fmaxf(bt + m, ml);
            SM[chain * 64 + c] = m; SA[chain * 64 + c] = expf(bt + m - mn); SB[chain * 64 + c] = expf(ml - mn); m = mn; }
        SM[512 + chain] = m; }
    __syncthreads();
    if (F.vcu == 0) { F.MS[F.tid] = SM[F.tid]; if (F.tid < 8) F.out[O_PM + F.tid] = SM[512 + F.tid]; }
    const int gt = F.vcu * 512 + F.tid, NT = F.G * 512;
    for (int ec = gt; ec < 8 * 25760; ec += NT) { const int chain = ec / 25760, el = ec - chain * 25760;
        float C = 0.f;
        const float* dc = F.DC + (size_t)chain * 64 * 25760 + el; bf16* cs = F.CS + (size_t)chain * 64 * 28160 + el;
        for (int c0 = 0; c0 < 64; c0 += 16) { float d[16];
#pragma unroll
            for (int j = 0; j < 16; ++j) d[j] = __builtin_nontemporal_load(dc + (size_t)(c0 + j) * 25760);
#pragma unroll
            for (int j = 0; j < 16; ++j) { cs[(size_t)(c0 + j) * 28160] = (bf16)(pk2(C, 0.f) & 0xffffu); C = SA[chain * 64 + c0 + j] * C + SB[chain * 64 + c0 + j] * d[j]; } }
        if (el < 25600) F.out[O_PC + (size_t)chain * 25600 + el] = C; else F.out[O_PN + (size_t)chain * 160 + (el - 25600)] = C;
    }
    __syncthreads();
}
__device__ __forceinline__ void mlstm_stageC_item(Frame& F, int item, bool flip) {
    int lane = F.lane; asm volatile("" : "+v"(lane));
    const int bh = item >> 6, c = item & 63, b = bh >> 2, h = bh & 3, fr = lane & 15, fq = lane >> 4, tid = lane + 64 * F.wave;
    const size_t row0 = (size_t)b * SEQ + (size_t)c * 128;
    LAS bf16* VT = (LAS bf16*)(F.lds + MC_VT);
    LAS float* GU = (LAS float*)(F.lds + MC_GA); LAS float* GM = GU + 128; LAS float* GW = GU + 256; LAS float* GE = GU + 384;
    __syncthreads();
    if (F.wave == 0) {
        const float gb_i = F.in[I_GB][h], gb_f = F.in[I_GB][4 + h], mprev = F.MS[item];
        const float* g0 = F.Gt + (row0 + 2 * lane) * 8;
        const float gi0 = g0[h] + gb_i, gf0 = g0[4 + h] + gb_f, gi1 = g0[8 + h] + gb_i, gf1 = g0[12 + h] + gb_f;
        const float lf0 = log_sigmoid(gf0), lf1 = log_sigmoid(gf1), pair = lf0 + lf1;
        float incl = pair;
#pragma unroll
        for (int o = 1; o < 64; o <<= 1) { const float t = __shfl_up(incl, o); if (lane >= o) incl += t; }
        const float a0 = (incl - pair) + lf0, a1 = incl;
        const float u0 = gi0 - a0, u1 = gi1 - a1;
        float pm = fmaxf(u0, u1);
#pragma unroll
        for (int o = 1; o < 64; o <<= 1) { const float t = __shfl_up(pm, o); if (lane >= o) pm = fmaxf(pm, t); }
        float pe = __shfl_up(pm, 1); if (lane == 0) pe = -1e30f;
        const float M0 = fmaxf(mprev, fmaxf(pe, u0)), M1 = fmaxf(mprev, pm);
        GU[2 * lane] = u0; GU[2 * lane + 1] = u1; GM[2 * lane] = M0; GM[2 * lane + 1] = M1;
        GW[2 * lane] = expf(mprev - M0); GW[2 * lane + 1] = expf(mprev - M1);
        GE[2 * lane] = expf(-(a0 + M0)); GE[2 * lane + 1] = expf(-(a1 + M1));
    }
    {
        v4u xv[5];
#pragma unroll
        for (int j = 0; j < 5; ++j) { const int idx = tid + 512 * j, t = idx / 20, cg = idx - t * 20; xv[j] = *(const v4u*)(F.Z + (row0 + t) * ZP + ZX + h * 160 + cg * 8); }
#pragma unroll
        for (int j = 0; j < 5; ++j) { const int idx = tid + 512 * j, t = idx / 20, cg = idx - t * 20; *(LAS v4u*)(VT + t * VTP + cg * 8) = xv[j]; }
    }
    mlstm_vt_ones(F, VT);
    __syncthreads();
    const int tw = flip ? 7 - F.wave : F.wave, t0 = 16 * tw, tq = t0 + fr;
    const size_t row = row0 + tq;
    bf16x8 qf[5];
#pragma unroll
    for (int kk = 0; kk < 5; ++kk) qf[kk] = *(const bf16x8*)(F.QB + row * DB + h * 160 + 32 * kk + 8 * fq);
    f32x4 acc[11];
    const float wst = GW[tq], Mt = GM[tq], en = GE[tq];
    {
        const bf16* cs = F.CS + (size_t)item * 28160 + (size_t)fr * 160 + 8 * fq;
#pragma unroll
        for (int vt = 0; vt < 11; ++vt) { f32x4 a = {0.f, 0.f, 0.f, 0.f};
#pragma unroll
            for (int kk = 0; kk < 5; ++kk) a = MFMA16(*(const bf16x8*)(cs + vt * 16 * 160 + 32 * kk), qf[kk], a);
            acc[vt] = a * wst; }
    }
    const int npair = (tw >> 1) + 1;
    const bf16* kbase = F.KB + (row0 + fr) * DB + h * 160 + 8 * fq;
    bf16x8 ka[5], kb[5];
#pragma unroll
    for (int kk = 0; kk < 5; ++kk) { ka[kk] = *(const bf16x8*)(kbase + 32 * kk); kb[kk] = *(const bf16x8*)(kbase + (size_t)16 * DB + 32 * kk); }
    for (int i = 0; i < npair; ++i) {
        bf16x8 na[5], nb[5];
        const bool more = i + 1 < npair;
        if (more) {
#pragma unroll
            for (int kk = 0; kk < 5; ++kk) { na[kk] = *(const bf16x8*)(kbase + (size_t)(32 * (i + 1)) * DB + 32 * kk); nb[kk] = *(const bf16x8*)(kbase + (size_t)(32 * (i + 1) + 16) * DB + 32 * kk); } }
        f32x4 sa = {0.f, 0.f, 0.f, 0.f}, sb = sa;
#pragma unroll
        for (int kk = 0; kk < 5; ++kk) { sa = MFMA16(ka[kk], qf[kk], sa); sb = MFMA16(kb[kk], qf[kk], sb); }
        const f32x4 ua = *(const LAS f32x4*)(GU + 32 * i + 4 * fq), ub = *(const LAS f32x4*)(GU + 32 * i + 16 + 4 * fq);
        float pa[4], pb[4];
#pragma unroll
        for (int r = 0; r < 4; ++r) { const int s0 = 32 * i + 4 * fq + r, s1 = s0 + 16;
            pa[r] = s0 <= tq ? sa[r] * __expf(ua[r] - Mt) : 0.f; pb[r] = s1 <= tq ? sb[r] * __expf(ub[r] - Mt) : 0.f; }
        v4u pw; pw.x = pk2(pa[0], pa[1]); pw.y = pk2(pa[2], pa[3]); pw.z = pk2(pb[0], pb[1]); pw.w = pk2(pb[2], pb[3]);
        const bf16x8 pf = __builtin_bit_cast(bf16x8, pw);
        const LAS bf16* vp = VT + (32 * i + 4 * fq + (fr >> 2)) * VTP + 4 * (fr & 3);
#pragma unroll
        for (int vt = 0; vt < 11; ++vt) { const bf16x8 a = cat8(tr_read(vp + vt * 16), tr_read(vp + 16 * VTP + vt * 16)); acc[vt] = MFMA16(a, pf, acc[vt]); }
        if (more) {
#pragma unroll
            for (int kk = 0; kk < 5; ++kk) { ka[kk] = na[kk]; kb[kk] = nb[kk]; } }
    }
    const float den = __shfl(acc[10][0], fr);
    const float inv = 1.0f / fmaxf(fabsf(den), en);
    float ss = 0.f;
#pragma unroll
    for (int vt = 0; vt < 10; ++vt) { acc[vt] = acc[vt] * inv; ss += (acc[vt][0] * acc[vt][0] + acc[vt][1] * acc[vt][1]) + (acc[vt][2] * acc[vt][2] + acc[vt][3] * acc[vt][3]); }
    ss += __shfl_xor(ss, 16); ss += __shfl_xor(ss, 32);
    const float rs = 1.0f / sqrtf(ss * (1.0f / 160.0f) + EPS);
#pragma unroll
    for (int vt = 0; vt < 10; ++vt) { const int ch = h * 160 + vt * 16 + 4 * fq;
        const v2u caw = *(const v2u*)(F.CAB + row * DB + ch);
        const v2u obw = *(const v2u*)(F.Z + row * ZP + ZO + ch);
        const f32x4 ca = {bflo(caw.x), bfhi(caw.x), bflo(caw.y), bfhi(caw.y)};
        const f32x4 ob = {bflo(obw.x), bfhi(obw.x), bflo(obw.y), bfhi(obw.y)};
        const f32x4 mg = *(const f32x4*)(F.in[I_MHG] + ch), sk = *(const f32x4*)(F.in[I_SKIP] + ch);
        float o[4];
#pragma unroll
        for (int e = 0; e < 4; ++e) o[e] = sigmoidf(ob[e]) * (acc[vt][e] * rs * mg[e] + sk[e] * ca[e]);
        v2u w; w.x = pk2(o[0], o[1]); w.y = pk2(o[2], o[3]);
        *(v2u*)(F.CAT + row * DM + DA + ch) = w; }
}
__device__ __forceinline__ void attn_combine_row(Frame& F, int row) {
    const int lane = F.lane;
    float o[6]; float ss = 0.f;
#pragma unroll
    for (int h = 0; h < 6; ++h) {
        const float l0 = F.LSE[(size_t)row * 6 + h], l1 = F.LSE[((size_t)MP + row) * 6 + h], l2 = F.LSE[((size_t)2 * MP + row) * 6 + h];
        const float mx = fmaxf(l0, fmaxf(l1, l2)), e0 = __expf(l0 - mx), e1 = __expf(l1 - mx), e2 = __expf(l2 - mx), inv = 1.0f / (e0 + e1 + e2);
        const float a0 = bf2f(F.AO[(size_t)row * DA + h * 64 + lane]), a1 = bf2f(F.AO[((size_t)MP + row) * DA + h * 64 + lane]), a2 = bf2f(F.AO[((size_t)2 * MP + row) * DA + h * 64 + lane]);
        o[h] = (e0 * a0 + e1 * a1 + e2 * a2) * inv; ss += o[h] * o[h]; }
    ss = wave_sum(ss);
    const float rstd = 1.0f / sqrtf(ss * (1.0f / 384.0f) + EPS);
#pragma unroll
    for (int h = 0; h < 6; ++h) F.CAT[(size_t)row * DM + h * 64 + lane] = (bf16)(pk2(o[h] * rstd * F.in[I_AOG][h * 64 + lane], 0.f) & 0xffffu);
}
__device__ __forceinline__ void final_norm_row(Frame& F, int m) {
    float* row = m < MP ? F.out + O_YP + (size_t)m * DM : F.out + O_YS + (size_t)(m - MP) * DM;
    f32x4* xr = (f32x4*)row + F.lane; const f32x4* gr = (const f32x4*)F.in[I_FG] + F.lane;
    f32x4 v[4]; float s = 0.f;
    if (m < MP) {
#pragma unroll
        for (int j = 0; j < 4; ++j) v[j] = xr[64 * j];
    } else {
        const f32x4* x1 = (const f32x4*)(F.X1 + (size_t)m * DM) + F.lane;
#pragma unroll
        for (int j = 0; j < 4; ++j) v[j] = x1[64 * j];
#pragma unroll
        for (int ks = 0; ks < 8; ++ks) { const f32x4* sl = (const f32x4*)(F.SLAB + ((size_t)ks * NS + (m - MP)) * DM) + F.lane;
#pragma unroll
            for (int j = 0; j < 4; ++j) v[j] = v[j] + sl[64 * j]; }
    }
#pragma unroll
    for (int j = 0; j < 4; ++j) s += (v[j].x * v[j].x + v[j].y * v[j].y) + (v[j].z * v[j].z + v[j].w * v[j].w);
    const float rstd = 1.0f / sqrtf(wave_sum(s) * (1.f / DM) + EPS);
#pragma unroll
    for (int j = 0; j < 4; ++j) xr[64 * j] = v[j] * rstd * gr[64 * j];
}

struct Args { const float* in[24]; float* out; unsigned char* ws; int ph_lo, ph_hi, li, pad; };
__global__ void __launch_bounds__(NWAVES * 64, 2) mega_fwd(Args args) {
    extern __shared__ __attribute__((aligned(16))) unsigned char lds[];
    Frame F;
    F.lds = (LAS unsigned char*)lds;
    F.MISC = (volatile LAS unsigned*)(F.lds + MISC_OFF);
    F.tid = threadIdx.x; F.lane = F.tid & 63; F.wave = __builtin_amdgcn_readfirstlane(F.tid >> 6);
    F.G = gridDim.x; { const int bx = blockIdx.x; F.vcu = (F.G % 8 == 0) ? (bx % 8) * (F.G / 8) + bx / 8 : bx; }
    unsigned char* ws = args.ws; F.ws = ws; F.out = args.out;
#pragma unroll
    for (int i = 0; i < 24; ++i) F.in[i] = args.in[i];
    F.ctl = (gu32*)(ws + WS_CTL);
    F.WIN = (bf16*)(ws + WS_WIN); F.WOUT = (bf16*)(ws + WS_WOUT); F.W1 = (bf16*)(ws + WS_W1); F.W2 = (bf16*)(ws + WS_W2); F.WQ = (bf16*)(ws + WS_WQ); F.WK = (bf16*)(ws + WS_WK);
    F.XN = (bf16*)(ws + WS_XN); F.Z = (bf16*)(ws + WS_Z); F.AO = (bf16*)(ws + WS_AO); F.CS = (bf16*)(ws + WS_CS); F.CAT = (bf16*)(ws + WS_CAT); F.X1B = (bf16*)(ws + WS_X1B); F.HFF = (bf16*)(ws + WS_HFF); F.QB = (bf16*)(ws + WS_QB); F.KB = (bf16*)(ws + WS_KB); F.CAB = (bf16*)(ws + WS_CAB);
    F.Gt = (float*)(ws + WS_G); F.SS1 = (float*)(ws + WS_SS1); F.SS2 = (float*)(ws + WS_SS2); F.ML = (float*)(ws + WS_ML); F.BT = (float*)(ws + WS_BT); F.MS = (float*)(ws + WS_MS);
    F.LSE = (float*)(ws + WS_LSE); F.DC = (float*)(ws + WS_DC); F.X1 = (float*)(ws + WS_X1); F.SLAB = (float*)(ws + WS_SLAB);
    for (int u = F.tid; u < (LDS_BYTES - LDSCTL_OFF) / 4; u += NWAVES * 64) ((LAS unsigned*)(F.lds + LDSCTL_OFF))[u] = 0u;
    __syncthreads();
    XcdBarrier bar; bar.bar = (unsigned*)(F.ctl + CW_BAR); bar.x = 0; bar.st = nullptr;
    if (N_LAUNCHES != PER_PHASE) bar = xcd_barrier_post((unsigned*)(F.ctl + CW_BAR), F.MISC + 8);
#define GRID_BAR() do { if (N_LAUNCHES != PER_PHASE) { if (STEAL) xcd_barrier_steal(bar, F); else xcd_barrier(bar); } } while (0)
    const int lo = args.ph_lo, hi = args.ph_hi;
#define IN(k) (lo <= (k) && (k) < hi)
#define BOTH(k) (IN(k) && IN((k) + 1))
    const int gw = F.vcu * NWAVES + F.wave, NGW = F.G * NWAVES;

    if (IN(0)) { p0_prologue(F); if (BOTH(0)) GRID_BAR(); }

    if (IN(1)) {
        const int xl = (int)blockIdx.x & 7, slot = (int)blockIdx.x >> 3;
        constexpr int P1_SLOTS = 27;
        if (slot < P1_SLOTS) {
            pg8::Gemm g{F.XN, F.WIN, MP, ZP, DM}; pg8::StaticOrder S; S.init(MP, ZP, 8 * P1_SLOTS, slot * 8 + xl);
            pg8::EpiZ E{F.Z, F.Gt};
            REP(3) pg8::gemm_phase<pg8::EpiZ, pg8::StaticOrder, true, true>(F.lds, g, S, E);
        } else {
            const int cw = (slot - P1_SLOTS) * 8 + xl;
            SEpiZ SE{F.Z, F.Gt};
            for (int u = cw; u < 80; u += 8 * (32 - P1_SLOTS)) small_gemm<2, SEpiZ>(F, F.XN + (size_t)MP * DM, F.WIN, DM, 0, DM, 32 * u, SE);
        }
        if (BOTH(1)) GRID_BAR();
    }

    if (IN(2)) {
        __syncthreads();
        LAS float* biasT = (LAS float*)(F.lds + P2_BIAS_OFF);
        build_bias_table(F, biasT);
        __syncthreads();
        { const int gt = F.vcu * 512 + F.tid, NT = F.G * 512;
          for (int idx = gt; idx < NBATCH * 2048 * (2 * DA / 8); idx += NT) { const int cg = idx % 96, rr = idx / 96, b = rr / 2048, t = rr % 2048;
              const v4u w = *(const v4u*)(F.Z + ((size_t)b * SEQ + (SEQ - 2048) + t) * ZP + ZK + cg * 8);
              const int col = cg * 8; float* dst = col < DA ? F.out + O_PWK + ((size_t)b * 2048 + t) * DA + col : F.out + O_PWV + ((size_t)b * 2048 + t) * DA + (col - DA);
              *(f32x4*)dst = (f32x4){bflo(w.x), bfhi(w.x), bflo(w.y), bfhi(w.y)}; *(f32x4*)(dst + 4) = (f32x4){bflo(w.z), bfhi(w.z), bflo(w.w), bfhi(w.w)}; }
          for (int idx = gt; idx < NBATCH * 3 * DB; idx += NT) { const int b = idx / (3 * DB), rr = (idx % (3 * DB)) / DB, ch = idx % DB;
              F.out[O_PCONV + idx] = bf2f(F.Z[((size_t)b * SEQ + (SEQ - 3) + rr) * ZP + ZX + ch]); } }
        { LAS float* obuf = (LAS float*)(F.lds + P2_VT_OFF);
          REP(4) for (int b = F.vcu; b < NS; b += F.G) attn_sample_item(F, b, biasT, obuf); }
        __syncthreads();
        { LAS bf16* vl = (LAS bf16*)(F.lds + P2_VT_OFF + F.wave * P2_VT_WAVE);
          const bool light = F.vcu < NS; const int nit = light ? 3 : 6, base = light ? gw * 3 : 3072 + (gw - NS * NWAVES) * 6;
          REP(5) for (int j = 0; j < nit; ++j) attn_prompt_item(F, base + j, vl, biasT); }
        __syncthreads();
        { LAS float* sb = (LAS float*)(F.lds);
          REP(6) for (int it = F.vcu; it < NS * HB; it += F.G) mlstm_sample_item(F, it, sb); }
        __syncthreads();
        REP(7) for (int it = F.vcu; it < 512; it += F.G) mlstm_stageA_item(F, it);
        if (BOTH(2)) GRID_BAR();
    }

    if (IN(3)) { if (F.vcu < 16) { SEpiX1 SE{F.in[I_XS], F.X1, F.X1B, F.SS1}; small_gemm<4, SEpiX1>(F, F.CAT + (size_t)MP * DM, F.WOUT, DM, 0, DM, 64 * F.vcu, SE); }
        REP(8) mlstm_scan(F); if (BOTH(3)) GRID_BAR(); }

    if (IN(4)) {
        REP(9) { bool flip = false; for (int it = F.vcu; it < 512; it += F.G) { mlstm_stageC_item(F, it, flip); flip = !flip; } }
        REP(10) for (int m = gw; m < MP; m += NGW) attn_combine_row(F, m);
        if (F.vcu < 128) { SEpiFF1 SE{F.HFF, F.SS1}; small_gemm<2, SEpiFF1>(F, F.X1B + (size_t)MP * DM, F.W1, DM, 0, DM, 32 * F.vcu, SE); }
        if (BOTH(4)) GRID_BAR();
    }

    if (IN(5)) {
        __syncthreads();
        pg8::Gemm g{F.CAT, F.WOUT, MP, DM, DM}; pg8::StaticOrder S; S.init(MP, DM, F.G, (int)blockIdx.x);
        pg8::EpiX1 E{F.in[I_XP], F.in[I_XS], F.X1, F.X1B, F.SS1};
        REP(11) pg8::gemm_phase<pg8::EpiX1, pg8::StaticOrder, true, true>(F.lds, g, S, E);
        { const int u = F.vcu & 31, ks = F.vcu >> 5; if (ks < 8) { SEpiSlab SE{F.SLAB + (size_t)ks * NS * DM}; small_gemm<2, SEpiSlab>(F, F.HFF + (size_t)MP * DFF, F.W2, DFF, 512 * ks, 512 * ks + 512, 32 * u, SE); } }
        if (BOTH(5)) GRID_BAR();
    }
    if (IN(6)) {
        const int xl = (int)blockIdx.x & 7, slot = (int)blockIdx.x >> 3;
        constexpr int P6_SLOTS = 26;
        if (slot < P6_SLOTS) {
            pg8::Gemm g{F.X1B, F.W1, MP, DFF, DM}; pg8::StaticOrder S; S.init(MP, DFF, 8 * P6_SLOTS, slot * 8 + xl);
            pg8::EpiFF1 E{F.HFF, F.SS1};
            pg8::gemm_phase<pg8::EpiFF1, pg8::StaticOrder, true, true>(F.lds, g, S, E);
        }
        if (BOTH(6)) GRID_BAR();
    }
    if (IN(7)) {
        pg8::Gemm g{F.HFF, F.W2, MP, DM, DFF}; pg8::StaticOrder S; S.init(MP, DM, F.G, (int)blockIdx.x);
        pg8::EpiX2 E{F.X1, F.out + O_YP, F.out + O_YS, F.SS2};
        REP(13) pg8::gemm_phase<pg8::EpiX2, pg8::StaticOrder, true, true>(F.lds, g, S, E);
        if (BOTH(7)) GRID_BAR();
    }
    if (IN(8)) { REP(14) for (int m = gw; m < MT; m += NGW) final_norm_row(F, m); REP(15) copy_drain(F); }
#undef IN
#undef BOTH
}

extern "C" void kernel_launch(void* const* d_in, const int* in_sizes, int n_in, void* d_out, int out_size, void* d_ws, size_t ws_size, hipStream_t stream) {
    static int grid = 0;
    if (grid == 0) {
        if (n_in != 24 || (size_t)out_size != O_END || ws_size < WS_END) { fprintf(stderr, "kernel_launch: unexpected sizes n_in %d out %d ws %zu\n", n_in, out_size, ws_size); grid = -1; return; }
        int dev = 0, cus = 0, per_cu = 0;
        if (hipGetDevice(&dev) != hipSuccess || hipDeviceGetAttribute(&cus, hipDeviceAttributeMultiprocessorCount, dev) != hipSuccess) { grid = -1; return; }
        if (hipFuncSetAttribute((const void*)mega_fwd, hipFuncAttributeMaxDynamicSharedMemorySize, LDS_BYTES) != hipSuccess) { fprintf(stderr, "kernel_launch: hipFuncSetAttribute failed\n"); grid = -1; return; }
        if (hipOccupancyMaxActiveBlocksPerMultiprocessor(&per_cu, (const void*)mega_fwd, NWAVES * 64, LDS_BYTES) != hipSuccess || per_cu < 1) { fprintf(stderr, "kernel_launch: occupancy query says %d blocks per CU\n", per_cu); (void)hipGetLastError(); grid = -1; return; }
        grid = cus;
    }
    if (grid < 0) return;
    (void)hipMemsetAsync((char*)d_ws + WS_CTL, 0, CTL_ZERO_BYTES, stream);
    Args a{};
    for (int i = 0; i < 24; ++i) a.in[i] = (const float*)d_in[i];
    a.out = (float*)d_out; a.ws = (unsigned char*)d_ws;
    if (N_LAUNCHES == PER_PHASE) {
        for (int li = 0; li < PER_PHASE; ++li) { a.ph_lo = li; a.ph_hi = li + 1; a.li = li; hipLaunchKernelGGL(mega_fwd, dim3(grid), dim3(NWAVES * 64), LDS_BYTES, stream, a); }
    } else {
        a.ph_lo = 0; a.ph_hi = PER_PHASE; a.li = 0;
        hipLaunchKernelGGL(mega_fwd, dim3(grid), dim3(NWAVES * 64), LDS_BYTES, stream, a);
    }
}
```

```cpp
#include <hip/hip_runtime.h>
#include <cstdio>
#include <cstdint>

constexpr int DM = 1024, SEQ = 8192, NBATCH = 2, MP = NBATCH * SEQ, NS = 128, MT = MP + NS, MPAD = 16640;
constexpr int DA = 384, DB = 640, HA = 6, HB = 4, EB = 160, DIN = 2440, ZP = 2560, DFF = 4096;
constexpr int ZQ = 0, ZK = 384, ZV = 768, ZX = 1152, ZO = 1792, ZG = 2432;
constexpr int PAST = 2048, NCH = 64, LCH = 128;
constexpr float EPS = 1e-6f;

namespace pg8 {
#define PG8_LAS __attribute__((address_space(3)))
typedef unsigned short bf16_t;
typedef short bf16x8 __attribute__((ext_vector_type(8)));
typedef float f32x4 __attribute__((ext_vector_type(4)));
typedef unsigned u32x4 __attribute__((ext_vector_type(4)));
constexpr int BM = 256, BK = 64, HALF = 128, HTB = HALF * BK * 2  , STAGE_BYTES = 8 * HTB, NXCD = 8, WGM = 8;

__host__ __device__ __forceinline__ int lds_byte(int r, int c) { const int st = (r >> 4) * 2 + (c >> 5), rr = r & 15, cc = c & 31, ob = rr * 64 + cc * 2; return st * 1024 + (ob ^ (((ob >> 9) & 1) << 5)); }
__host__ __device__ __forceinline__ void stage_rc(int b, int& R, int& C) { const int st = b / 1024, sb = b % 1024, swz = sb ^ (((sb >> 9) & 1) << 5); R = (st >> 1) * 16 + swz / 64; C = (st & 1) * 32 + (swz % 64) / 2; }
__host__ __device__ __forceinline__ int perm32(int rho) { const int n = rho >> 4, i = rho & 15; return 8 * (i >> 2) + 4 * n + (i & 3); }

struct Unit { int pm, pn; };
struct Gemm { const bf16_t* A; const bf16_t* Bt; int M, N, K; };

struct StaticOrder {
    int nM, nN, nwg, G, c;
    __host__ __device__ void init(int M, int N, int G_, int c_) { nM = M / BM; nN = N / BM; nwg = nM * nN; G = G_; c = c_; }
    __host__ __device__ bool next(int i, Unit& u) const {
        const long L = (long)i * G + c; if (L >= nwg) return false;
        int wgid = (int)L; { const int q = nwg / NXCD, r = nwg % NXCD, xcd = wgid % NXCD, off = wgid / NXCD; wgid = (xcd < r ? xcd * (q + 1) : r * (q + 1) + (xcd - r) * q) + off; }
        const int nig = WGM * nN, gid = wgid / nig, fm = gid * WGM, gsz = (nM - fm) < WGM ? (nM - fm) : WGM;
        u.pm = fm + ((wgid % nig) % gsz); u.pn = (wgid % nig) / gsz; return true;
    }
    __device__ __forceinline__ void a_ready(const Unit&) const {}
    __device__ __forceinline__ void done(const Unit&) const {}
};


typedef float f32x2 __attribute__((ext_vector_type(2)));
typedef __bf16 bf16x2_t __attribute__((ext_vector_type(2)));
typedef unsigned u32x2 __attribute__((ext_vector_type(2)));
__device__ __forceinline__ unsigned cvt_pk_bf16(float lo, float hi) { f32x2 v = {lo, hi}; bf16x2_t b = __builtin_convertvector(v, bf16x2_t); return __builtin_bit_cast(unsigned, b); }

struct EpiZ {
    static constexpr bool PERM = true, AFTER_DRAIN = false;
    bf16_t* Z; float* G;
    __device__ __forceinline__ void operator()(const f32x4 (&acc)[2][2][4][2], const Unit& u, int wr, int wc, int fr, int fq) const {
        const int row0 = u.pm * BM + wr * 64 + fr, col0 = u.pn * BM + wc * 32 + 8 * fq;
        const bool gates = (u.pn == 9) && (wc == 0) && (fq == 0);
#pragma unroll
        for (int ai = 0; ai < 2; ++ai)
#pragma unroll
            for (int m = 0; m < 4; ++m) { const int row = row0 + ai * HALF + m * 16; bf16_t* rowp = Z + (size_t)row * 2560 + col0;
#pragma unroll
                for (int bj = 0; bj < 2; ++bj) { const f32x4 v0 = acc[ai][bj][m][0], v1 = acc[ai][bj][m][1];
                    u32x4 w; w.x = cvt_pk_bf16(v0[0], v0[1]); w.y = cvt_pk_bf16(v0[2], v0[3]); w.z = cvt_pk_bf16(v1[0], v1[1]); w.w = cvt_pk_bf16(v1[2], v1[3]);
                    *(u32x4*)(rowp + bj * HALF) = w; }
                if (gates) { *(f32x4*)(G + (size_t)row * 8) = acc[ai][1][m][0]; *(f32x4*)(G + (size_t)row * 8 + 4) = acc[ai][1][m][1]; } }
    }
};
struct EpiX1 {
    static constexpr bool PERM = false, AFTER_DRAIN = false;
    const float* xp; const float* xs; float* X1; bf16_t* X1B; float* SS;
    __device__ __forceinline__ void operator()(const f32x4 (&acc)[2][2][4][2], const Unit& u, int wr, int wc, int fr, int fq) const {
        const int row0 = u.pm * BM + wr * 64 + fr, col0 = u.pn * BM + wc * 32 + 4 * fq;
#pragma unroll
        for (int ai = 0; ai < 2; ++ai)
#pragma unroll
            for (int m = 0; m < 4; ++m) { const int row = row0 + ai * HALF + m * 16;
                const float* xr = row < 16384 ? xp + (size_t)row * 1024 : (row < 16512 ? xs + (size_t)(row - 16384) * 1024 : nullptr);
                float ss = 0.f;
#pragma unroll
                for (int bj = 0; bj < 2; ++bj)
#pragma unroll
                    for (int n = 0; n < 2; ++n) { const int col = col0 + bj * HALF + n * 16;
                        f32x4 xv = {0.f, 0.f, 0.f, 0.f}; if (xr) xv = *(const f32x4*)(xr + col);
                        const f32x4 v = acc[ai][bj][m][n] + xv;
                        *(f32x4*)(X1 + (size_t)row * 1024 + col) = v;
                        u32x2 w; w.x = cvt_pk_bf16(v[0], v[1]); w.y = cvt_pk_bf16(v[2], v[3]); *(u32x2*)(X1B + (size_t)row * 1024 + col) = w;
                        ss += (v[0] * v[0] + v[1] * v[1]) + (v[2] * v[2] + v[3] * v[3]); }
                ss += __shfl_xor(ss, 16); ss += __shfl_xor(ss, 32);
                if (fq == 0) SS[(size_t)row * 16 + u.pn * 4 + wc] = ss; }
    }
};
struct EpiFF1 {
    static constexpr bool PERM = true, AFTER_DRAIN = false;
    bf16_t* H; const float* SS;
    __device__ __forceinline__ void operator()(const f32x4 (&acc)[2][2][4][2], const Unit& u, int wr, int wc, int fr, int fq) const {
        const int row0 = u.pm * BM + wr * 64 + fr, col0 = u.pn * BM + wc * 32 + 8 * fq;
#pragma unroll
        for (int ai = 0; ai < 2; ++ai)
#pragma unroll
            for (int m = 0; m < 4; ++m) { const int row = row0 + ai * HALF + m * 16;
                const f32x4* sp = (const f32x4*)(SS + (size_t)row * 16); const f32x4 s0 = sp[0], s1 = sp[1], s2 = sp[2], s3 = sp[3];
                const float tot = ((s0[0] + s0[1]) + (s0[2] + s0[3])) + ((s1[0] + s1[1]) + (s1[2] + s1[3])) + ((s2[0] + s2[1]) + (s2[2] + s2[3])) + ((s3[0] + s3[1]) + (s3[2] + s3[3]));
                const float rstd = 1.0f / sqrtf(tot * (1.0f / 1024.0f) + 1e-6f);
                bf16_t* rowp = H + (size_t)row * 4096 + col0;
#pragma unroll
                for (int bj = 0; bj < 2; ++bj) { f32x4 v0 = acc[ai][bj][m][0] * rstd, v1 = acc[ai][bj][m][1] * rstd;
#pragma unroll
                    for (int e = 0; e < 4; ++e) { const float a = fmaxf(v0[e], 0.f), b = fmaxf(v1[e], 0.f); v0[e] = a * a; v1[e] = b * b; }
                    u32x4 w; w.x = cvt_pk_bf16(v0[0], v0[1]); w.y = cvt_pk_bf16(v0[2], v0[3]); w.z = cvt_pk_bf16(v1[0], v1[1]); w.w = cvt_pk_bf16(v1[2], v1[3]);
                    *(u32x4*)(rowp + bj * HALF) = w; } }
    }
};
struct EpiX2 {
    static constexpr bool PERM = false, AFTER_DRAIN = false;
    const float* X1; float* yp; float* ys; float* SS;
    __device__ __forceinline__ void operator()(const f32x4 (&acc)[2][2][4][2], const Unit& u, int wr, int wc, int fr, int fq) const {
        const int row0 = u.pm * BM + wr * 64 + fr, col0 = u.pn * BM + wc * 32 + 4 * fq;
#pragma unroll
        for (int ai = 0; ai < 2; ++ai)
#pragma unroll
            for (int m = 0; m < 4; ++m) { const int row = row0 + ai * HALF + m * 16;
                float* orow = row < 16384 ? yp + (size_t)row * 1024 : (row < 16512 ? ys + (size_t)(row - 16384) * 1024 : nullptr);
                float ss = 0.f;
#pragma unroll
                for (int bj = 0; bj < 2; ++bj)
#pragma unroll
                    for (int n = 0; n < 2; ++n) { const int col = col0 + bj * HALF + n * 16;
                        const f32x4 v = acc[ai][bj][m][n] + *(const f32x4*)(X1 + (size_t)row * 1024 + col);
                        if (orow) *(f32x4*)(orow + col) = v;
                        ss += (v[0] * v[0] + v[1] * v[1]) + (v[2] * v[2] + v[3] * v[3]); }
                ss += __shfl_xor(ss, 16); ss += __shfl_xor(ss, 32);
                if (fq == 0) SS[(size_t)row * 16 + u.pn * 4 + wc] = ss; }
    }
};

template <class Epi, class Sched, bool ALIGN_EPI = false, bool SP2 = false>
__device__ __forceinline__ void gemm_phase(PG8_LAS unsigned char* lds, const Gemm g, const Sched& S, const Epi& E) {
    const int tid = threadIdx.x, wid = __builtin_amdgcn_readfirstlane(tid >> 6), lane = tid & 63, wr = wid >> 2, wc = wid & 3, fr = lane & 15, fq = lane >> 4;
    const int K = g.K, nt = K / BK;
    unsigned voffA[2], voffB[2];
#pragma unroll
    for (int i = 0; i < 2; ++i) { int R, C; stage_rc(tid * 16 + i * 8192, R, C); const int Rb = Epi::PERM ? ((R & ~31) + perm32(R & 31)) : R;
        voffA[i] = (unsigned)(R * K + C) * 2u; voffB[i] = (unsigned)(Rb * K + C) * 2u; }
    const size_t kstep = (size_t)(BK * 2);
    const size_t hstep = (size_t)HALF * K * 2;
    const size_t tstep = 2 * hstep;
    const unsigned ldsw = (unsigned)wid * 1024u;
    const int aoff = lds_byte(wr * 64 + fr, fq * 8), boff = lds_byte(wc * 32 + fr, fq * 8);
#define PG8_SA(b, h) (((b) * 2 + (h)) * HTB)
#define PG8_SB(b, h) ((4 + (b) * 2 + (h)) * HTB)
#define PG8_STAGE(bufoff, gbase, voff) do { _Pragma("unroll") for (int _i = 0; _i < 2; ++_i) \
        __builtin_amdgcn_global_load_lds((const unsigned*)((const char*)(gbase) + (voff)[_i]), (PG8_LAS unsigned*)(lds + (bufoff) + ldsw + _i * 8192), 16, 0, 0); } while (0)
#define PG8_LDA(dst, b, h) do { _Pragma("unroll") for (int m = 0; m < 4; ++m) _Pragma("unroll") for (int k = 0; k < 2; ++k) dst[m][k] = *(const PG8_LAS bf16x8*)(lds + PG8_SA(b, h) + aoff + m * 2048 + k * 1024); } while (0)
#define PG8_LDB(dst, b, h) do { _Pragma("unroll") for (int n = 0; n < 2; ++n) _Pragma("unroll") for (int k = 0; k < 2; ++k) dst[n][k] = *(const PG8_LAS bf16x8*)(lds + PG8_SB(b, h) + boff + n * 2048 + k * 1024); } while (0)
#define PG8_MMA(ai, bj, At, Bt) do { __builtin_amdgcn_s_setprio(1); _Pragma("unroll") for (int m = 0; m < 4; ++m) _Pragma("unroll") for (int n = 0; n < 2; ++n) _Pragma("unroll") for (int k = 0; k < 2; ++k) \
        acc[ai][bj][m][n] = __builtin_amdgcn_mfma_f32_16x16x32_bf16(Bt[n][k], At[m][k], acc[ai][bj][m][n], 0, 0, 0); __builtin_amdgcn_s_setprio(0); } while (0)
#define PG8_WAIT_V(n) asm volatile("s_waitcnt vmcnt(" #n ")" ::: "memory")
#define PG8_WAIT_L(n) asm volatile("s_waitcnt lgkmcnt(" #n ")" ::: "memory")
#define PG8_BAR __builtin_amdgcn_s_barrier()
#define PG8_SCHED __builtin_amdgcn_sched_barrier(0)
    Unit cur, nxt; int ui = 0;
    if (!S.next(0, cur)) return;
    f32x4 acc[2][2][4][2];
#pragma unroll
    for (int a = 0; a < 2; ++a)
#pragma unroll
        for (int b = 0; b < 2; ++b)
#pragma unroll
            for (int m = 0; m < 4; ++m)
#pragma unroll
                for (int n = 0; n < 2; ++n) acc[a][b][m][n] = (f32x4){0.f, 0.f, 0.f, 0.f};
    bf16x8 At[4][2], B0[2][2], B1[2][2];
    const char* cA = (const char*)g.A + (size_t)cur.pm * tstep; const char* cB = (const char*)g.Bt + (size_t)cur.pn * tstep;
    S.a_ready(cur);
    if constexpr (SP2) {
        PG8_STAGE(PG8_SB(0, 0), cB, voffB); PG8_STAGE(PG8_SB(0, 1), cB + hstep, voffB); PG8_STAGE(PG8_SA(0, 0), cA, voffA); PG8_STAGE(PG8_SA(0, 1), cA + hstep, voffA);
        if (wr == 1) PG8_BAR;
        PG8_WAIT_V(2); PG8_BAR;
        PG8_STAGE(PG8_SB(1, 0), cB + kstep, voffB); PG8_STAGE(PG8_SA(1, 0), cA + kstep, voffA); PG8_STAGE(PG8_SB(1, 1), cB + hstep + kstep, voffB);
        PG8_WAIT_V(6); PG8_BAR;
    } else {
        PG8_STAGE(PG8_SB(0, 0), cB, voffB); PG8_STAGE(PG8_SA(0, 0), cA, voffA); PG8_STAGE(PG8_SB(0, 1), cB + hstep, voffB); PG8_STAGE(PG8_SA(0, 1), cA + hstep, voffA);
        if (wr == 1) PG8_BAR;
        PG8_WAIT_V(4); PG8_BAR;
        PG8_STAGE(PG8_SB(1, 0), cB + kstep, voffB); PG8_STAGE(PG8_SA(1, 0), cA + kstep, voffA); PG8_STAGE(PG8_SB(1, 1), cB + hstep + kstep, voffB);
        PG8_WAIT_V(6); PG8_BAR;
    }
    for (;;) {
        const bool has_next = S.next(ui + 1, nxt);
        const char* nA = has_next ? (const char*)g.A + (size_t)nxt.pm * tstep : cA; const char* nB = has_next ? (const char*)g.Bt + (size_t)nxt.pn * tstep : cB;
        for (int t = 0; t < nt; t += 2) {
            const bool last = (t == nt - 2);
            const char* a1 = cA + (size_t)(t + 1) * kstep;
            const char* a2 = last ? nA : cA + (size_t)(t + 2) * kstep; const char* b2 = last ? nB : cB + (size_t)(t + 2) * kstep;
            const char* a3 = a2 + kstep; const char* b3 = b2 + kstep;
            if (last && has_next) S.a_ready(nxt);
            if constexpr (SP2) {
            PG8_LDB(B0, 0, 0); PG8_LDB(B1, 0, 1); PG8_SCHED; PG8_LDA(At, 0, 0); PG8_STAGE(PG8_SA(1, 1), a1 + hstep, voffA);
            PG8_WAIT_V(8); PG8_WAIT_L(0); PG8_BAR; PG8_MMA(0, 0, At, B0); PG8_MMA(0, 1, At, B1); PG8_BAR; PG8_SCHED;
            PG8_LDA(At, 0, 1); PG8_STAGE(PG8_SB(0, 0), b2, voffB); PG8_STAGE(PG8_SB(0, 1), b2 + hstep, voffB); PG8_STAGE(PG8_SA(0, 0), a2, voffA);
            PG8_WAIT_V(8); PG8_WAIT_L(0); PG8_BAR; PG8_MMA(1, 0, At, B0); PG8_MMA(1, 1, At, B1); PG8_BAR; PG8_SCHED;
            PG8_LDB(B0, 1, 0); PG8_LDB(B1, 1, 1); PG8_SCHED; PG8_LDA(At, 1, 0); PG8_STAGE(PG8_SA(0, 1), a2 + hstep, voffA);
            PG8_WAIT_V(8); PG8_WAIT_L(0); PG8_BAR; PG8_MMA(0, 0, At, B0); PG8_MMA(0, 1, At, B1); PG8_BAR; PG8_SCHED;
            PG8_LDA(At, 1, 1); PG8_STAGE(PG8_SB(1, 0), b3, voffB); PG8_STAGE(PG8_SB(1, 1), b3 + hstep, voffB); PG8_STAGE(PG8_SA(1, 0), a3, voffA);
            PG8_WAIT_V(8); PG8_WAIT_L(0); PG8_BAR; PG8_MMA(1, 0, At, B0); PG8_MMA(1, 1, At, B1); PG8_BAR; PG8_SCHED;
            } else {
            PG8_LDB(B0, 0, 0); PG8_SCHED; PG8_LDA(At, 0, 0); PG8_STAGE(PG8_SA(1, 1), a1 + hstep, voffA);
            PG8_WAIT_L(8); PG8_BAR; PG8_WAIT_L(0); PG8_MMA(0, 0, At, B0); PG8_BAR; PG8_SCHED;
            PG8_LDB(B1, 0, 1); PG8_STAGE(PG8_SB(0, 0), b2, voffB);
            PG8_BAR; PG8_WAIT_L(0); PG8_MMA(0, 1, At, B1); PG8_BAR;
            PG8_LDA(At, 0, 1); PG8_STAGE(PG8_SA(0, 0), a2, voffA);
            PG8_BAR; PG8_WAIT_L(0); PG8_MMA(1, 0, At, B0); PG8_BAR; PG8_SCHED;
            PG8_STAGE(PG8_SB(0, 1), b2 + hstep, voffB);
            PG8_WAIT_V(6); PG8_BAR; PG8_MMA(1, 1, At, B1); PG8_BAR;
            PG8_LDB(B0, 1, 0); PG8_SCHED; PG8_LDA(At, 1, 0); PG8_STAGE(PG8_SA(0, 1), a2 + hstep, voffA);
            PG8_WAIT_L(8); PG8_BAR; PG8_WAIT_L(0); PG8_MMA(0, 0, At, B0); PG8_BAR; PG8_SCHED;
            PG8_LDB(B1, 1, 1); PG8_STAGE(PG8_SB(1, 0), b3, voffB);
            PG8_BAR; PG8_WAIT_L(0); PG8_MMA(0, 1, At, B1); PG8_BAR;
            PG8_LDA(At, 1, 1); PG8_STAGE(PG8_SA(1, 0), a3, voffA);
            PG8_BAR; PG8_WAIT_L(0); PG8_MMA(1, 0, At, B0); PG8_BAR; PG8_SCHED;
            PG8_STAGE(PG8_SB(1, 1), b3 + hstep, voffB);
            PG8_WAIT_V(6); PG8_BAR; PG8_MMA(1, 1, At, B1); PG8_BAR;
            }
        }
        if constexpr (ALIGN_EPI) { if (wr == 0) PG8_BAR; }
        if constexpr (!Epi::AFTER_DRAIN) { E(acc, cur, wr, wc, fr, fq); S.done(cur); }
        if (!has_next) break;
#pragma unroll
        for (int a = 0; a < 2; ++a)
#pragma unroll
            for (int b = 0; b < 2; ++b)
#pragma unroll
                for (int m = 0; m < 4; ++m)
#pragma unroll
                    for (int n = 0; n < 2; ++n) acc[a][b][m][n] = (f32x4){0.f, 0.f, 0.f, 0.f};
        cur = nxt; cA = nA; cB = nB; ++ui;
        if constexpr (ALIGN_EPI) { if (wr == 1) PG8_BAR; }
    }
    PG8_WAIT_V(0);
    if constexpr (!ALIGN_EPI) { if (wr == 0) PG8_BAR; }
    PG8_BAR;
    if constexpr (Epi::AFTER_DRAIN) { E.fused(acc, cur, wr, wc, fr, fq, lds, wid, lane); S.done(cur); }
#undef PG8_SA
#undef PG8_SB
#undef PG8_STAGE
#undef PG8_LDA
#undef PG8_LDB
#undef PG8_MMA
#undef PG8_WAIT_V
#undef PG8_WAIT_L
#undef PG8_BAR
#undef PG8_SCHED
}
}


#ifndef DUP_ID
#define DUP_ID 0
#endif
#ifndef DUP_N
#define DUP_N 2
#endif
#ifndef STEAL
#define STEAL 1
#endif
__device__ __forceinline__ bool launder_lane(int& a, int& b) { asm volatile("" : "+v"(a), "+v"(b)); return true; }
#define PH(k) for (int ph_ = 0; ph_ < (DUP_ID == 100 + (k) ? 1 + DUP_N : 1) && launder_lane(F_tid_ref, F_lane_ref); ++ph_)
#define REP(id) for (int rep_ = 0; rep_ < (DUP_ID == (id) ? 1 + DUP_N : 1); ++rep_)
#ifndef MK_N_LAUNCHES
#define MK_N_LAUNCHES 1
#endif
constexpr int NWAVES = 8;
constexpr int PER_PHASE = 9;
constexpr int N_LAUNCHES = MK_N_LAUNCHES;

constexpr size_t MiB = 1u << 20;
constexpr size_t WS_CTL = 0, CTL_ZERO_BYTES = 1 * MiB;
constexpr size_t WS_WIN = 2 * MiB, WS_WOUT = 7 * MiB, WS_W1 = 9 * MiB, WS_W2 = 17 * MiB, WS_WQ = 25 * MiB, WS_WK = 25 * MiB + 256 * 1024;
constexpr size_t WS_SLAB = 526 * MiB;
constexpr size_t WS_QB = 530 * MiB, WS_KB = 551 * MiB, WS_CAB = 572 * MiB;
constexpr size_t WS_G = 26 * MiB, WS_SS1 = 27 * MiB, WS_SS2 = 29 * MiB, WS_ML = 31 * MiB, WS_BT = 31 * MiB + 4096, WS_MS = 31 * MiB + 8192;
constexpr size_t WS_LSE = 32 * MiB, WS_XN = 34 * MiB, WS_Z = 67 * MiB, WS_AO = 149 * MiB, WS_DC = 185 * MiB, WS_CS = 236 * MiB, WS_CAT = 264 * MiB;
constexpr size_t WS_X1 = 297 * MiB, WS_X1B = 362 * MiB, WS_HFF = 395 * MiB, WS_END = 593 * MiB;
static_assert(WS_XN + (size_t)MPAD * DM * 2 <= WS_Z && WS_Z + (size_t)MPAD * ZP * 2 <= WS_AO && WS_AO + (size_t)3 * MP * DA * 2 <= WS_DC, "ws map 1");
static_assert(WS_DC + (size_t)512 * 161 * 160 * 4 <= WS_CS && WS_CS + (size_t)512 * 176 * 160 * 2 <= WS_CAT && WS_CAT + (size_t)MPAD * DM * 2 <= WS_X1, "ws map 2");
static_assert(WS_X1 + (size_t)MPAD * DM * 4 <= WS_X1B && WS_X1B + (size_t)MPAD * DM * 2 <= WS_HFF && WS_HFF + (size_t)MPAD * DFF * 2 <= WS_SLAB, "ws map 3");
static_assert(WS_SS1 + (size_t)MPAD * 16 * 4 <= WS_SS2 && WS_SS2 + (size_t)MPAD * 16 * 4 <= WS_ML && WS_LSE + (size_t)3 * MP * 6 * 4 <= WS_XN && WS_G + (size_t)MPAD * 8 * 4 <= WS_SS1, "ws map 4");
constexpr int CW_TMO = 0, CW_COPYQ = 64, CW_BAR = 4096;
constexpr unsigned CP_BURST4 = 8192, CP_PER_SLICE = 24, CP_N4 = 2047 * DA / 4, CP_NQ = 2 * NS * CP_PER_SLICE;

constexpr size_t O_YP = 0, O_YS = O_YP + (size_t)MP * DM, O_PWK = O_YS + (size_t)NS * DM, O_PWV = O_PWK + (size_t)NBATCH * 2048 * DA, O_PCONV = O_PWV + (size_t)NBATCH * 2048 * DA;
constexpr size_t O_PC = O_PCONV + (size_t)NBATCH * 3 * DB, O_PN = O_PC + (size_t)NBATCH * HB * EB * EB, O_PM = O_PN + (size_t)NBATCH * HB * EB, O_SWK = O_PM + (size_t)NBATCH * HB;
constexpr size_t O_SWV = O_SWK + (size_t)NS * 2048 * DA, O_SCONV = O_SWV + (size_t)NS * 2048 * DA, O_SC = O_SCONV + (size_t)NS * 3 * DB, O_SN = O_SC + (size_t)NS * HB * EB * EB;
constexpr size_t O_SM = O_SN + (size_t)NS * HB * EB, O_END = O_SM + (size_t)NS * HB;

constexpr int RING_BYTES = 155648;
constexpr int LDSCTL_OFF = RING_BYTES, MISC_OFF = LDSCTL_OFF + 320;
constexpr int LDS_BYTES = RING_BYTES + 512;
static_assert(pg8::STAGE_BYTES <= RING_BYTES, "GEMM stage buffers fit");

#define GAS __attribute__((address_space(1)))
#define LAS __attribute__((address_space(3)))
typedef unsigned short bf16;
typedef unsigned v4u __attribute__((ext_vector_type(4)));
typedef unsigned v2u __attribute__((ext_vector_type(2)));
typedef float f32x4 __attribute__((ext_vector_type(4)));
typedef float f32x16 __attribute__((ext_vector_type(16)));
typedef short bf16x8 __attribute__((ext_vector_type(8)));
typedef short s16x4 __attribute__((ext_vector_type(4)));
typedef short v4i16_t __attribute__((ext_vector_type(4)));
typedef GAS unsigned gu32;
#define RLX_AGENT __ATOMIC_RELAXED, __HIP_MEMORY_SCOPE_AGENT
#define LDS_WAIT() asm volatile("s_waitcnt lgkmcnt(0)" ::: "memory")
#define VM_WAIT() asm volatile("s_waitcnt vmcnt(0)" ::: "memory")
#define CFENCE() asm volatile("" ::: "memory")
__device__ __forceinline__ unsigned pk2(float lo, float hi) { return pg8::cvt_pk_bf16(lo, hi); }
__device__ __forceinline__ float bf2f(unsigned short x) { return __uint_as_float((unsigned)x << 16); }
__device__ __forceinline__ float bflo(unsigned w) { return __uint_as_float(w << 16); }
__device__ __forceinline__ float bfhi(unsigned w) { return __uint_as_float(w & 0xffff0000u); }
__device__ __forceinline__ s16x4 tr_read(const LAS bf16* p) { return __builtin_bit_cast(s16x4, __builtin_amdgcn_ds_read_tr16_b64_v4i16((LAS v4i16_t*)p)); }
__device__ __forceinline__ bf16x8 cat8(s16x4 a, s16x4 b) { return (bf16x8){a[0], a[1], a[2], a[3], b[0], b[1], b[2], b[3]}; }
#define MFMA16(a, b, c) __builtin_amdgcn_mfma_f32_16x16x32_bf16((a), (b), (c), 0, 0, 0)
#define MFMA32(a, b, c) __builtin_amdgcn_mfma_f32_32x32x16_bf16((a), (b), (c), 0, 0, 0)
__device__ __forceinline__ int crow(int r, int hi) { return (r & 3) + 8 * (r >> 2) + 4 * hi; }
__device__ __forceinline__ float wave_sum(float v) {
#pragma unroll
    for (int o = 1; o < 64; o <<= 1) v += __shfl_xor(v, o);
    return v;
}
__device__ __forceinline__ float wave_max(float v) {
#pragma unroll
    for (int o = 1; o < 64; o <<= 1) v = fmaxf(v, __shfl_xor(v, o));
    return v;
}
__device__ __forceinline__ float log_sigmoid(float x) { return -(fmaxf(-x, 0.f) + log1pf(expf(-fabsf(x)))); }
__device__ __forceinline__ float sigmoidf(float x) { return 1.0f / (1.0f + expf(-x)); }
__device__ __forceinline__ float siluf(float x) { return x / (1.0f + expf(-x)); }

#define XB_TMO      128
#define XB_XCNT(j)  (256  + 64 * (j))
#define XB_XSUB(j)  (1280 + 64 * (j))
#define XB_XGEN(j)  (2304 + 64 * (j))
#define XB_TOP      3328
#define XB_TOPGEN   3392
#define XCD_BAR_WORDS 3456
#define XB_SPIN_CAP (1u << 18)

__device__ __forceinline__ unsigned xb_ld(unsigned* p)              { return __hip_atomic_load(p, __ATOMIC_RELAXED, __HIP_MEMORY_SCOPE_AGENT); }
__device__ __forceinline__ unsigned xb_add(unsigned* p, unsigned v) { return __hip_atomic_fetch_add(p, v, __ATOMIC_RELAXED, __HIP_MEMORY_SCOPE_AGENT); }
__device__ __forceinline__ unsigned xb_xcc_id() { return (unsigned)__builtin_amdgcn_s_getreg((3 << 11) | 20) & 0xFu; }
#define XB_SPIN(cond, bar) do { unsigned _sp = 0; while (cond) { __builtin_amdgcn_s_sleep(1); \
    if ((++_sp & 255u) == 0u) { if (xb_ld(&(bar)[XB_TMO])) break; if (_sp > XB_SPIN_CAP) { atomicAdd(&(bar)[XB_TMO], 1u); break; } } } } while (0)

struct XcdBarrier {
    unsigned* bar; unsigned x;
    volatile LAS unsigned* st;
};

__device__ __forceinline__ XcdBarrier xcd_barrier_post(unsigned* bar, volatile LAS unsigned* st) {
    XcdBarrier b; b.bar = bar; b.x = xb_xcc_id(); b.st = st;
    if (threadIdx.x == 0) (void)xb_add(&bar[XB_XCNT(b.x)], 1u);
    return b;
}
__device__ __forceinline__ void xcd_barrier_complete(unsigned* bar, unsigned x, unsigned& nloc, unsigned& nx) {
    const unsigned G = gridDim.x * gridDim.y * gridDim.z;
    unsigned sum, cnt, mine, sp = 0u;
    for (;;) {
        sum = 0u; cnt = 0u; mine = 0u;
#pragma unroll
        for (unsigned j = 0; j < 16; ++j) { const unsigned c = xb_ld(&bar[XB_XCNT(j)]); sum += c; cnt += (c > 0u) ? 1u : 0u; mine = (j == x) ? c : mine; }
        if (sum == G) break;
        __builtin_amdgcn_s_sleep(1);
        if ((++sp & 255u) == 0u) { if (xb_ld(&bar[XB_TMO])) break; if (sp > XB_SPIN_CAP) { atomicAdd(&bar[XB_TMO], 1u); break; } }
    }
    nloc = mine > 0u ? mine : 1u; nx = cnt > 0u ? cnt : 1u;
}

__device__ __forceinline__ void xcd_barrier(const XcdBarrier& b) {
    asm volatile("s_waitcnt vmcnt(0)" ::: "memory");
    __syncthreads();
    if (threadIdx.x == 0) {
        unsigned* bar = b.bar;
        __builtin_amdgcn_s_waitcnt(0);
        unsigned nloc = b.st[0], nx = b.st[1];
        if (nloc == 0u) { xcd_barrier_complete(bar, b.x, nloc, nx); b.st[0] = nloc; b.st[1] = nx; }
        const unsigned old = xb_add(&bar[XB_XSUB(b.x)], 1u);
        const unsigned gen = old / nloc;
        if (old + 1u == (gen + 1u) * nloc) {
            __builtin_amdgcn_fence(__ATOMIC_RELEASE, "agent");
            asm volatile("s_waitcnt vmcnt(0)" ::: "memory");
            const unsigned og = xb_add(&bar[XB_TOP], 1u);
            const unsigned tg = og / nx;
            if (og + 1u == (tg + 1u) * nx) xb_add(&bar[XB_TOPGEN], 1u);
            else XB_SPIN(xb_ld(&bar[XB_TOPGEN]) == tg, bar);
            __builtin_amdgcn_fence(__ATOMIC_ACQUIRE, "agent");
            xb_add(&bar[XB_XGEN(b.x)], 1u);
            asm volatile("s_waitcnt vmcnt(0)" ::: "memory");
        } else {
            XB_SPIN(xb_ld(&bar[XB_XGEN(b.x)]) == gen, bar);
            __builtin_amdgcn_fence(__ATOMIC_ACQUIRE, "agent");
            asm volatile("s_waitcnt vmcnt(0)" ::: "memory");
        }
    }
    __syncthreads();
}


struct Frame {
    LAS unsigned char* lds;
    volatile LAS unsigned* MISC;
    gu32* ctl;
    int tid, lane, wave;
    int vcu, G;
    const float* in[24]; float* out; unsigned char* ws;
    bf16 *WIN, *WOUT, *W1, *W2, *WQ, *WK, *XN, *Z, *AO, *CS, *CAT, *X1B, *HFF, *QB, *KB, *CAB;
    float *Gt, *SS1, *SS2, *ML, *BT, *MS, *LSE, *DC, *X1, *SLAB;
};
enum { I_XP = 0, I_XS, I_CK, I_CV, I_SCONV, I_SC, I_SN, I_SM, I_RELB, I_N1G, I_WIN, I_GB, I_CW, I_CB, I_WQ, I_WK, I_AOG, I_MHG, I_SKIP, I_WOUT, I_N2G, I_W1, I_W2, I_FG };


__device__ __forceinline__ void copy_burst(Frame& F, unsigned q) {
    const unsigned s = q / CP_PER_SLICE, k = q - s * CP_PER_SLICE, tsel = s >> 7, b = s & 127u;
    const f32x4* src = (const f32x4*)((tsel ? F.in[I_CV] : F.in[I_CK]) + (size_t)b * 2048 * DA + DA);
    f32x4* dst = (f32x4*)(F.out + (tsel ? O_SWV : O_SWK) + (size_t)b * 2048 * DA);
    const unsigned i0 = k * CP_BURST4 + (unsigned)F.tid;
    f32x4 v[16];
#pragma unroll
    for (int j = 0; j < 16; ++j) { const unsigned i = i0 + 512u * j; if (i < CP_N4) v[j] = __builtin_nontemporal_load(src + i); }
#pragma unroll
    for (int j = 0; j < 16; ++j) { const unsigned i = i0 + 512u * j; if (i < CP_N4) __builtin_nontemporal_store(v[j], dst + i); }
}
__device__ __forceinline__ void xcd_barrier_steal(const XcdBarrier& b, Frame& F) {
    asm volatile("s_waitcnt vmcnt(0)" ::: "memory");
    __syncthreads();
    volatile LAS unsigned* sw = F.MISC + 12;
    unsigned gen = 0u; bool leader = true;
    if (threadIdx.x == 0) {
        unsigned* bar = b.bar;
        __builtin_amdgcn_s_waitcnt(0);
        unsigned nloc = b.st[0], nx = b.st[1];
        if (nloc == 0u) { xcd_barrier_complete(bar, b.x, nloc, nx); b.st[0] = nloc; b.st[1] = nx; }
        const unsigned old = xb_add(&bar[XB_XSUB(b.x)], 1u);
        gen = old / nloc;
        if (old + 1u == (gen + 1u) * nloc) {
            __builtin_amdgcn_fence(__ATOMIC_RELEASE, "agent");
            asm volatile("s_waitcnt vmcnt(0)" ::: "memory");
            const unsigned og = xb_add(&bar[XB_TOP], 1u);
            const unsigned tg = og / nx;
            if (og + 1u == (tg + 1u) * nx) xb_add(&bar[XB_TOPGEN], 1u);
            else XB_SPIN(xb_ld(&bar[XB_TOPGEN]) == tg, bar);
            __builtin_amdgcn_fence(__ATOMIC_ACQUIRE, "agent");
            xb_add(&bar[XB_XGEN(b.x)], 1u);
            asm volatile("s_waitcnt vmcnt(0)" ::: "memory");
            sw[0] = 0u;
        } else { leader = false; sw[0] = 1u; }
    }
    unsigned iters = 0u;
    for (;;) {
        __syncthreads();
        if (threadIdx.x == 0 && !leader) {
            if (xb_ld(&b.bar[XB_XGEN(b.x)]) != gen || xb_ld(&b.bar[XB_TMO]) != 0u) sw[0] = 0u;
            else { unsigned q = CP_NQ; if (sw[2] == 0u) { q = __hip_atomic_fetch_add((unsigned*)(F.ctl + CW_COPYQ), 1u, __ATOMIC_RELAXED, __HIP_MEMORY_SCOPE_AGENT); if (q >= CP_NQ) sw[2] = 1u; } sw[1] = q;
                   if (++iters > (1u << 22)) { atomicAdd(&b.bar[XB_TMO], 1u); sw[0] = 0u; } }
        }
        __syncthreads();
        if (sw[0] == 0u) break;
        const unsigned q = sw[1];
        if (q < CP_NQ) copy_burst(F, q); else __builtin_amdgcn_s_sleep(8);
    }
    if (threadIdx.x == 0 && !leader) { __builtin_amdgcn_fence(__ATOMIC_ACQUIRE, "agent"); asm volatile("s_waitcnt vmcnt(0)" ::: "memory"); }
    __syncthreads();
}
__device__ __forceinline__ void copy_drain(Frame& F) {
    volatile LAS unsigned* sw = F.MISC + 12;
    for (;;) {
        __syncthreads();
        if (threadIdx.x == 0) { unsigned q = CP_NQ; if (sw[2] == 0u) { q = __hip_atomic_fetch_add((unsigned*)(F.ctl + CW_COPYQ), 2u, __ATOMIC_RELAXED, __HIP_MEMORY_SCOPE_AGENT); if (q >= CP_NQ) sw[2] = 1u; } sw[1] = q; }
        __syncthreads();
        const unsigned q = sw[1];
        if (q >= CP_NQ) break;
        copy_burst(F, q); if (q + 1u < CP_NQ) copy_burst(F, q + 1u);
    }
}

template <int NT, class Epi>
__device__ __forceinline__ void small_gemm(Frame& F, const bf16* A, const bf16* Bt, int K, int kbeg, int kend, int n0, const Epi& E) {
    const int fr = F.lane & 15, fq = F.lane >> 4, r = 16 * F.wave + fr;
    const bf16* ap = A + (size_t)r * K + 8 * fq;
    const bf16* bp = Bt + (size_t)(n0 + fr) * K + 8 * fq;
    f32x4 acc[NT];
#pragma unroll
    for (int nt = 0; nt < NT; ++nt) acc[nt] = (f32x4){0.f, 0.f, 0.f, 0.f};
    bf16x8 a0[4], b0[NT][4], a1[4], b1[NT][4];
#define SG_LOAD(a_, b_, k_) do { _Pragma("unroll") for (int j = 0; j < 4; ++j) { a_[j] = *(const bf16x8*)(ap + (k_) + 32 * j); \
        _Pragma("unroll") for (int nt = 0; nt < NT; ++nt) b_[nt][j] = *(const bf16x8*)(bp + (size_t)nt * 16 * K + (k_) + 32 * j); } } while (0)
#define SG_MMA(a_, b_) do { _Pragma("unroll") for (int j = 0; j < 4; ++j) _Pragma("unroll") for (int nt = 0; nt < NT; ++nt) acc[nt] = MFMA16(b_[nt][j], a_[j], acc[nt]); } while (0)
    SG_LOAD(a0, b0, kbeg);
    for (int k = kbeg; k < kend; k += 256) {
        SG_LOAD(a1, b1, k + 128);
        SG_MMA(a0, b0);
        if (k + 256 < kend) SG_LOAD(a0, b0, k + 256);
        SG_MMA(a1, b1);
    }
#undef SG_LOAD
#undef SG_MMA
    E(acc, r, n0, fq);
}
struct SEpiZ { bf16* Z; float* G;
    __device__ __forceinline__ void operator()(const f32x4 (&acc)[2], int r, int n0, int fq) const {
#pragma unroll
        for (int nt = 0; nt < 2; ++nt) { const int col = n0 + 16 * nt + 4 * fq; v2u w; w.x = pk2(acc[nt][0], acc[nt][1]); w.y = pk2(acc[nt][2], acc[nt][3]);
            *(v2u*)(Z + (size_t)(MP + r) * ZP + col) = w;
            if (col >= ZG && col < ZG + 8) *(f32x4*)(G + (size_t)(MP + r) * 8 + (col - ZG)) = acc[nt]; } } };
struct SEpiX1 { const float* xs; float* X1; bf16* X1B; float* SS;
    __device__ __forceinline__ void operator()(const f32x4 (&acc)[4], int r, int n0, int fq) const {
        float ss = 0.f;
#pragma unroll
        for (int nt = 0; nt < 4; ++nt) { const int col = n0 + 16 * nt + 4 * fq; const f32x4 v = acc[nt] + *(const f32x4*)(xs + (size_t)r * DM + col);
            *(f32x4*)(X1 + (size_t)(MP + r) * DM + col) = v; v2u w; w.x = pk2(v[0], v[1]); w.y = pk2(v[2], v[3]); *(v2u*)(X1B + (size_t)(MP + r) * DM + col) = w;
            ss += (v[0] * v[0] + v[1] * v[1]) + (v[2] * v[2] + v[3] * v[3]); }
        ss += __shfl_xor(ss, 16); ss += __shfl_xor(ss, 32);
        if (fq == 0) SS[(size_t)(MP + r) * 16 + (n0 >> 6)] = ss; } };
struct SEpiFF1 { bf16* H; const float* SS;
    __device__ __forceinline__ void operator()(const f32x4 (&acc)[2], int r, int n0, int fq) const {
        const f32x4* sp = (const f32x4*)(SS + (size_t)(MP + r) * 16); const f32x4 s0 = sp[0], s1 = sp[1], s2 = sp[2], s3 = sp[3];
        const float tot = ((s0[0] + s0[1]) + (s0[2] + s0[3])) + ((s1[0] + s1[1]) + (s1[2] + s1[3])) + ((s2[0] + s2[1]) + (s2[2] + s2[3])) + ((s3[0] + s3[1]) + (s3[2] + s3[3]));
        const float rstd = 1.0f / sqrtf(tot * (1.0f / 1024.0f) + EPS);
#pragma unroll
        for (int nt = 0; nt < 2; ++nt) { const int col = n0 + 16 * nt + 4 * fq; float o[4];
#pragma unroll
            for (int e = 0; e < 4; ++e) { const float a = fmaxf(acc[nt][e] * rstd, 0.f); o[e] = a * a; }
            v2u w; w.x = pk2(o[0], o[1]); w.y = pk2(o[2], o[3]); *(v2u*)(H + (size_t)(MP + r) * DFF + col) = w; } } };
struct SEpiSlab { float* slab;
    __device__ __forceinline__ void operator()(const f32x4 (&acc)[2], int r, int n0, int fq) const {
#pragma unroll
        for (int nt = 0; nt < 2; ++nt) { const int col = n0 + 16 * nt + 4 * fq; *(f32x4*)(slab + (size_t)r * DM + col) = acc[nt]; } } };

__device__ __forceinline__ void p0_transpose_item(const float* W, int K, int N, int Npad, const float* gain, bf16* WT, LAS float* scr, int item, int lane) {
    const int nblk = Npad / 32, kb = item / nblk, nb = item % nblk, k0 = 64 * kb, n0 = 32 * nb;
    const int nn = n0 + (lane & 31);
#pragma unroll
    for (int i = 0; i < 32; ++i) { const int kk = 2 * i + (lane >> 5); float w = nn < N ? W[(size_t)(k0 + kk) * N + nn] : 0.f; if (gain) w *= gain[k0 + kk]; scr[kk * 33 + (lane & 31)] = w; }
    LDS_WAIT(); CFENCE();
    const int c = lane & 7;
#pragma unroll
    for (int j = 0; j < 4; ++j) { const int n = (lane >> 3) + 8 * j; const LAS float* s = scr + (8 * c) * 33 + n;
        v4u o; o.x = pk2(s[0 * 33], s[1 * 33]); o.y = pk2(s[2 * 33], s[3 * 33]); o.z = pk2(s[4 * 33], s[5 * 33]); o.w = pk2(s[6 * 33], s[7 * 33]);
        *(GAS v4u*)(WT + (size_t)(n0 + n) * K + k0 + 8 * c) = o; }
    LDS_WAIT(); CFENCE();
}
__device__ __forceinline__ void p0_prologue(Frame& F) {
    LAS float* scr = (LAS float*)(F.lds + F.wave * 16384);
    const int gw = F.vcu * NWAVES + F.wave, NGW = F.G * NWAVES;
    const int gt = F.vcu * 512 + F.tid, NT = F.G * 512;
    REP(1) {
    constexpr int I_IN = 16 * 80, I_OUT = 16 * 32, I_1 = 16 * 128, I_2 = 64 * 32, NITEMS = I_IN + I_OUT + I_1 + I_2;
    for (int it = gw; it < NITEMS; it += NGW) {
        int r = it;
        if (r < I_IN) { p0_transpose_item(F.in[I_WIN], DM, DIN, ZP, F.in[I_N1G], F.WIN, scr, r, F.lane); continue; } r -= I_IN;
        if (r < I_OUT) { p0_transpose_item(F.in[I_WOUT], DM, DM, DM, nullptr, F.WOUT, scr, r, F.lane); continue; } r -= I_OUT;
        if (r < I_1) { p0_transpose_item(F.in[I_W1], DM, DFF, DFF, F.in[I_N2G], F.W1, scr, r, F.lane); continue; } r -= I_1;
        p0_transpose_item(F.in[I_W2], DFF, DM, DM, nullptr, F.W2, scr, r, F.lane);
    }
    for (int idx = gt; idx < 2 * 102400; idx += NT) { const int mat = idx / 102400, r = idx % 102400, h = r / 25600, e = (r % 25600) / 160, d = r % 160;
        const float s = (mat ? F.in[I_WK] : F.in[I_WQ])[h * 25600 + d * 160 + e] * (mat ? 0.07905694150420949f : 1.0f);
        (mat ? F.WK : F.WQ)[h * 25600 + e * 160 + d] = (bf16)(pk2(s, 0.f) & 0xffffu); }
    for (int m0 = gw; m0 < MT; m0 += 2 * NGW) {
        const int m1 = m0 + NGW; const bool has1 = m1 < MT; const int m1c = has1 ? m1 : m0;
        const float* x0 = m0 < MP ? F.in[I_XP] + (size_t)m0 * DM : F.in[I_XS] + (size_t)(m0 - MP) * DM;
        const float* x1 = m1c < MP ? F.in[I_XP] + (size_t)m1c * DM : F.in[I_XS] + (size_t)(m1c - MP) * DM;
        const GAS f32x4* xr0 = (const GAS f32x4*)x0 + F.lane; const GAS f32x4* xr1 = (const GAS f32x4*)x1 + F.lane;
        f32x4 v[4], u[4]; float s0 = 0.f, s1 = 0.f;
#pragma unroll
        for (int j = 0; j < 4; ++j) { v[j] = xr0[64 * j]; u[j] = xr1[64 * j]; }
#pragma unroll
        for (int j = 0; j < 4; ++j) { s0 += (v[j].x * v[j].x + v[j].y * v[j].y) + (v[j].z * v[j].z + v[j].w * v[j].w); s1 += (u[j].x * u[j].x + u[j].y * u[j].y) + (u[j].z * u[j].z + u[j].w * u[j].w); }
        const float r0 = 1.0f / sqrtf(wave_sum(s0) * (1.f / DM) + EPS), r1 = 1.0f / sqrtf(wave_sum(s1) * (1.f / DM) + EPS);
        GAS unsigned long long* o0 = (GAS unsigned long long*)(F.XN + (size_t)m0 * DM) + F.lane; GAS unsigned long long* o1 = (GAS unsigned long long*)(F.XN + (size_t)m1c * DM) + F.lane;
#pragma unroll
        for (int j = 0; j < 4; ++j) o0[64 * j] = (unsigned long long)pk2(v[j].x * r0, v[j].y * r0) | ((unsigned long long)pk2(v[j].z * r0, v[j].w * r0) << 32);
        if (has1) {
#pragma unroll
            for (int j = 0; j < 4; ++j) o1[64 * j] = (unsigned long long)pk2(u[j].x * r1, u[j].y * r1) | ((unsigned long long)pk2(u[j].z * r1, u[j].w * r1) << 32); }
    }
    for (int idx = gt; idx < NS * 2 * DB; idx += NT) { const int b = idx / (2 * DB), rr = (idx % (2 * DB)) / DB, ch = idx % DB;
        F.out[O_SCONV + (size_t)b * 3 * DB + rr * DB + ch] = F.in[I_SCONV][(size_t)b * 3 * DB + (rr + 1) * DB + ch]; }
    }
}

__device__ __forceinline__ int t5_bucket(int dist) {
    if (dist < 16) return dist;
    const int large = 16 + (int)(logf((float)dist / 16.0f) / 4.852030263919617f * 16.0f);
    return large < 31 ? large : 31;
}
__device__ __forceinline__ void build_bias_table(Frame& F, LAS float* bt) {
    for (int idx = F.tid; idx < 18 * 132; idx += 512) { const int gh = idx / 132, j = idx % 132, g = gh / 6, h = gh % 6;
        bt[idx] = j <= 128 ? F.in[I_RELB][t5_bucket(j << (2 * g)) * 6 + h] : 0.f; }
}
constexpr int VPITCH = 72;
constexpr int P2_BIAS_OFF = 0, P2_VT_OFF = 18 * 132 * 4, P2_VT_WAVE = 32 * VPITCH * 2;
__device__ __forceinline__ void attn_prompt_item(Frame& F, int item, LAS bf16* vl, const LAS float* biasT) {
    const int lane = F.lane, r32 = lane & 31, hi = lane >> 5;
    const int g = item / 3072, rem = item - g * 3072, bh = rem >> 8, tile = rem & 255, b = bh / 6, h = bh - b * 6;
    const int sh = 2 * g, nper = 256 >> sh, r = tile / nper, n = tile & (nper - 1);
    const bf16* Zb = F.Z + (size_t)b * SEQ * ZP;
    const int tq = ((32 * n + r32) << sh) + r;
    bf16x8 qf[4];
    { const bf16* qrow = Zb + (size_t)tq * ZP + ZQ + h * 64 + 8 * hi;
#pragma unroll
      for (int kk = 0; kk < 4; ++kk) qf[kk] = *(const bf16x8*)(qrow + 16 * kk); }
    f32x16 o0, o1;
#pragma unroll
    for (int i = 0; i < 16; ++i) { o0[i] = 0.f; o1[i] = 0.f; }
    float mrun = -1e30f, lrun = 0.f;
    const LAS float* bt = biasT + (g * 6 + h) * 132;
    const LAS bf16* trb = vl + (4 * hi + ((lane & 15) >> 2)) * VPITCH + 16 * ((lane >> 4) & 1) + 4 * (lane & 3);
    int kt = n < 4 ? 4 - n : 0;
    bf16x8 kf[4]; v4u vr[4];
#define AP_LOAD(kf_, vr_, kt_) do { const int uk0_ = 32 * n - 128 + 32 * (kt_); \
        const bf16* krow_ = Zb + (size_t)(((uk0_ + r32) << sh) + r) * ZP + ZK + h * 64 + 8 * hi; \
        _Pragma("unroll") for (int kk = 0; kk < 4; ++kk) kf_[kk] = *(const bf16x8*)(krow_ + 16 * kk); \
        const v4u* vrow_ = (const v4u*)(Zb + (size_t)(((uk0_ + (lane >> 1)) << sh) + r) * ZP + ZV + h * 64 + (lane & 1) * 32); \
        _Pragma("unroll") for (int kk = 0; kk < 4; ++kk) vr_[kk] = vrow_[kk]; } while (0)
    AP_LOAD(kf, vr, kt);
    for (; kt < 5; ++kt) {
        bf16x8 kn[4]; v4u vn[4];
        const bool more = kt < 4;
        if (more) AP_LOAD(kn, vn, kt + 1);
        { LAS v4u* dst = (LAS v4u*)(vl + (lane >> 1) * VPITCH + (lane & 1) * 32); dst[0] = vr[0]; dst[1] = vr[1]; dst[2] = vr[2]; dst[3] = vr[3]; }
        f32x16 st;
#pragma unroll
        for (int i = 0; i < 16; ++i) st[i] = 0.f;
#pragma unroll
        for (int kk = 0; kk < 4; ++kk) st = MFMA32(kf[kk], qf[kk], st);
        const int jb = r32 + 128 - 32 * kt;
        float mt = -1e30f;
#pragma unroll
        for (int i = 0; i < 16; ++i) { const int j = jb - crow(i, hi); const bool ok = (j >= 0) && (j <= 128); const int jc = j < 0 ? 0 : (j > 128 ? 128 : j);
            const float s = ok ? st[i] * 0.125f + bt[jc] : -1e30f; st[i] = s; mt = fmaxf(mt, s); }
        mt = fmaxf(mt, __shfl_xor(mt, 32));
        const float mnew = fmaxf(mrun, mt), alpha = __expf(mrun - mnew);
        float ps = 0.f;
#pragma unroll
        for (int i = 0; i < 16; ++i) { const float p = __expf(st[i] - mnew); st[i] = p; ps += p; }
        ps += __shfl_xor(ps, 32);
        lrun = lrun * alpha + ps; mrun = mnew;
#pragma unroll
        for (int i = 0; i < 16; ++i) { o0[i] *= alpha; o1[i] *= alpha; }
        v4u p0, p1;
        p0.x = pk2(st[0], st[1]); p0.y = pk2(st[2], st[3]); p0.z = pk2(st[4], st[5]); p0.w = pk2(st[6], st[7]);
        p1.x = pk2(st[8], st[9]); p1.y = pk2(st[10], st[11]); p1.z = pk2(st[12], st[13]); p1.w = pk2(st[14], st[15]);
        const bf16x8 pb0 = __builtin_bit_cast(bf16x8, p0), pb1 = __builtin_bit_cast(bf16x8, p1);
        LDS_WAIT(); CFENCE();
        { const bf16x8 a00 = cat8(tr_read(trb), tr_read(trb + 8 * VPITCH));
          const bf16x8 a01 = cat8(tr_read(trb + 16 * VPITCH), tr_read(trb + 24 * VPITCH));
          const bf16x8 a10 = cat8(tr_read(trb + 32), tr_read(trb + 8 * VPITCH + 32));
          const bf16x8 a11 = cat8(tr_read(trb + 16 * VPITCH + 32), tr_read(trb + 24 * VPITCH + 32));
          o0 = MFMA32(a00, pb0, o0); o0 = MFMA32(a01, pb1, o0);
          o1 = MFMA32(a10, pb0, o1); o1 = MFMA32(a11, pb1, o1); }
        LDS_WAIT(); CFENCE();
        if (more) {
#pragma unroll
            for (int kk = 0; kk < 4; ++kk) { kf[kk] = kn[kk]; vr[kk] = vn[kk]; } }
    }
#undef AP_LOAD
    const float inv = 1.0f / lrun, lse = mrun + logf(lrun);
    const size_t orow = (size_t)g * MP + (size_t)b * SEQ + tq;
    bf16* op = F.AO + orow * DA + h * 64 + 4 * hi;
#pragma unroll
    for (int k = 0; k < 4; ++k) { v2u w; w.x = pk2(o0[4 * k] * inv, o0[4 * k + 1] * inv); w.y = pk2(o0[4 * k + 2] * inv, o0[4 * k + 3] * inv); *(v2u*)(op + 8 * k) = w;
                                  v2u w2; w2.x = pk2(o1[4 * k] * inv, o1[4 * k + 1] * inv); w2.y = pk2(o1[4 * k + 2] * inv, o1[4 * k + 3] * inv); *(v2u*)(op + 32 + 8 * k) = w2; }
    if (hi == 0) F.LSE[orow * 6 + h] = lse;
}

__device__ __forceinline__ void attn_sample_item(Frame& F, int b, const LAS float* biasT, LAS float* obuf  ) {
    const int lane = F.lane, sub = lane >> 4, d4 = lane & 15, h = F.wave;
    const bf16* zrow = F.Z + (size_t)(MP + b) * ZP;
    __syncthreads();
    if (h < 6) {
        f32x4 q; { const v2u w = *(const v2u*)(zrow + ZQ + h * 64 + 4 * d4); q = (f32x4){bflo(w.x), bfhi(w.x), bflo(w.y), bfhi(w.y)}; }
        f32x4 kn, vn; { const v2u w = *(const v2u*)(zrow + ZK + h * 64 + 4 * d4); kn = (f32x4){bflo(w.x), bfhi(w.x), bflo(w.y), bfhi(w.y)};
                        const v2u w2 = *(const v2u*)(zrow + ZV + h * 64 + 4 * d4); vn = (f32x4){bflo(w2.x), bfhi(w2.x), bflo(w2.y), bfhi(w2.y)}; }
        if (sub == 0) { *(f32x4*)(F.out + O_SWK + ((size_t)b * 2048 + 2047) * DA + h * 64 + 4 * d4) = kn; *(f32x4*)(F.out + O_SWV + ((size_t)b * 2048 + 2047) * DA + h * 64 + 4 * d4) = vn; }
        const float* ck = F.in[I_CK] + (size_t)b * 2048 * DA + h * 64 + 4 * d4; const float* cv = F.in[I_CV] + (size_t)b * 2048 * DA + h * 64 + 4 * d4;
        float m = -1e30f, l = 0.f; f32x4 o = {0.f, 0.f, 0.f, 0.f};
        for (int it0 = 0; it0 < 97; it0 += 8) {
            f32x4 kb[8], vb[8];
#pragma unroll
            for (int u = 0; u < 8; ++u) { const int idx = 4 * (it0 + u) + sub; const int ic = idx < 387 ? idx : 386; const int g = ic / 129, j = ic - g * 129;
                const int row = j ? 2048 - (j << (2 * g)) : 2047; kb[u] = *(const f32x4*)(ck + (size_t)row * DA); vb[u] = *(const f32x4*)(cv + (size_t)row * DA); }
#pragma unroll
            for (int u = 0; u < 8; ++u) { const int idx = 4 * (it0 + u) + sub; const bool ok = idx < 387; const int ic = ok ? idx : 386; const int g = ic / 129, j = ic - g * 129;
                const f32x4 kk = j ? kb[u] : kn, vv = j ? vb[u] : vn;
                float s = (q[0] * kk[0] + q[1] * kk[1]) + (q[2] * kk[2] + q[3] * kk[3]);
                s += __shfl_xor(s, 1); s += __shfl_xor(s, 2); s += __shfl_xor(s, 4); s += __shfl_xor(s, 8);
                s = ok ? s * 0.125f + biasT[(g * 6 + h) * 132 + j] : -1e30f;
                const float mn = fmaxf(m, s), al = __expf(m - mn), p = ok ? __expf(s - mn) : 0.f;
                l = l * al + p; o = o * al + vv * p; m = mn; }
        }
        float M = fmaxf(m, __shfl_xor(m, 16)); M = fmaxf(M, __shfl_xor(M, 32));
        const float sc = __expf(m - M); l *= sc; o = o * sc;
        l += __shfl_xor(l, 16); l += __shfl_xor(l, 32);
#pragma unroll
        for (int e = 0; e < 4; ++e) { o[e] += __shfl_xor(o[e], 16); o[e] += __shfl_xor(o[e], 32); }
        if (sub == 0) { const float inv = 1.0f / l; *(LAS f32x4*)(obuf + h * 64 + 4 * d4) = o * inv; }
    }
    __syncthreads();
    if (F.tid < 384) {
        float ss = 0.f;
#pragma unroll
        for (int k = 0; k < 6; ++k) { const float v = obuf[k * 64 + lane]; ss += v * v; }
        ss = wave_sum(ss);
        const float rstd = 1.0f / sqrtf(ss * (1.0f / 384.0f) + EPS);
        const int c = F.tid;
        F.CAT[(size_t)(MP + b) * DM + c] = (bf16)(pk2(obuf[c] * rstd * F.in[I_AOG][c], 0.f) & 0xffffu);
    }
}

__device__ __forceinline__ void mlstm_sample_item(Frame& F, int item, LAS float* sb  ) {
    const int b = item >> 2, h = item & 3, tid = F.tid, lane = F.lane;
    LAS float* cact = sb; LAS float* vv = sb + 160; LAS float* qv = sb + 320; LAS float* kv = sb + 480; LAS float* hv = sb + 640; LAS float* red = sb + 800;
    const bf16* zrow = F.Z + (size_t)(MP + b) * ZP;
    __syncthreads();
    if (tid < 160) { const int ch = h * 160 + tid; const float x3 = bf2f(zrow[ZX + ch]);
        const float* sc = F.in[I_SCONV] + (size_t)b * 3 * DB + ch; const float* cw = F.in[I_CW] + ch;
        const float c = F.in[I_CB][ch] + cw[0] * sc[0] + cw[DB] * sc[DB] + cw[2 * DB] * sc[2 * DB] + cw[3 * DB] * x3;
        cact[tid] = siluf(c); vv[tid] = x3; F.out[O_SCONV + (size_t)b * 3 * DB + 2 * DB + ch] = x3; }
    __syncthreads();
    if (tid < 320) { const int e = tid % 160, mat = tid / 160; const v4u* W = (const v4u*)((mat ? F.WK : F.WQ) + (size_t)h * 25600 + e * 160);
        v4u wv[20];
#pragma unroll
        for (int c8 = 0; c8 < 20; ++c8) wv[c8] = W[c8];
        float s = 0.f;
#pragma unroll
        for (int c8 = 0; c8 < 20; ++c8) { const LAS float* ca = cact + 8 * c8;
            s += (ca[0] * bflo(wv[c8].x) + ca[1] * bfhi(wv[c8].x)) + (ca[2] * bflo(wv[c8].y) + ca[3] * bfhi(wv[c8].y)) + (ca[4] * bflo(wv[c8].z) + ca[5] * bfhi(wv[c8].z)) + (ca[6] * bflo(wv[c8].w) + ca[7] * bfhi(wv[c8].w)); }
        if (mat) kv[e] = s; else qv[e] = s; }
    __syncthreads();
    const float gi = F.Gt[(size_t)(MP + b) * 8 + h] + F.in[I_GB][h], gf = F.Gt[(size_t)(MP + b) * 8 + 4 + h] + F.in[I_GB][4 + h];
    const float a = log_sigmoid(gf), m0 = F.in[I_SM][b * 4 + h];
    const float mt = fmaxf(a + m0, gi), wst = expf(a + m0 - mt), wkk = expf(gi - mt);
    const float* nst = F.in[I_SN] + (size_t)(b * 4 + h) * 160;
    float qk = 0.f, nq = 0.f;
    for (int e = lane; e < 160; e += 64) { qk += qv[e] * kv[e]; nq += nst[e] * qv[e]; }
    qk = wave_sum(qk); nq = wave_sum(nq);
    const float A = qk * wkk, den = wst * nq + A, denom = fmaxf(fabsf(den), expf(-mt));
    const float* Cst = F.in[I_SC] + (size_t)(b * 4 + h) * 25600; float* Cout = F.out + O_SC + (size_t)(b * 4 + h) * 25600;
    {
        const int gl = lane >> 3, jl = lane & 7;
        f32x4 c4[3][5];
#pragma unroll
        for (int p = 0; p < 3; ++p) { const int rl = p * 8 + gl; const bool ok = rl < 20; const int v = F.wave * 20 + (ok ? rl : 0);
#pragma unroll
            for (int i = 0; i < 5; ++i) c4[p][i] = __builtin_nontemporal_load((const f32x4*)(Cst + v * 160) + jl + 8 * i); }
#pragma unroll
        for (int p = 0; p < 3; ++p) { const int rl = p * 8 + gl; const bool ok = rl < 20; const int v = F.wave * 20 + (ok ? rl : 0);
            const float wv = wkk * vv[v]; float dot = 0.f;
#pragma unroll
            for (int i = 0; i < 5; ++i) { const f32x4 q4 = *(const LAS f32x4*)(qv + 4 * (jl + 8 * i)), k4 = *(const LAS f32x4*)(kv + 4 * (jl + 8 * i));
                dot += (c4[p][i][0] * q4[0] + c4[p][i][1] * q4[1]) + (c4[p][i][2] * q4[2] + c4[p][i][3] * q4[3]);
                const f32x4 cn = c4[p][i] * wst + k4 * wv;
                if (ok) __builtin_nontemporal_store(cn, (f32x4*)(Cout + v * 160) + jl + 8 * i); }
            dot += __shfl_xor(dot, 1); dot += __shfl_xor(dot, 2); dot += __shfl_xor(dot, 4);
            if (ok && jl == 0) hv[v] = (wst * dot + A * vv[v]) / denom; }
    }
    __syncthreads();
    if (tid < 160) F.out[O_SN + (size_t)(b * 4 + h) * 160 + tid] = wst * nst[tid] + wkk * kv[tid];
    if (tid == 0) F.out[O_SM + b * 4 + h] = mt;
    float ss = 0.f;
    for (int e = lane; e < 160; e += 64) ss += hv[e] * hv[e];
    ss = wave_sum(ss);
    const float rs = 1.0f / sqrtf(ss * (1.0f / 160.0f) + EPS);
    if (tid < 160) { const int ch = h * 160 + tid; const float hb = hv[tid] * rs * F.in[I_MHG][ch]; const float ob = bf2f(zrow[ZO + ch]);
        const float o = sigmoidf(ob) * (hb + F.in[I_SKIP][ch] * cact[tid]);
        F.CAT[(size_t)(MP + b) * DM + DA + ch] = (bf16)(pk2(o, 0.f) & 0xffffu); }
}

constexpr int CAP = 168, VTP = 176;
constexpr int ML_CA = 0, ML_KS = 128 * CAP * 2, ML_VT = 2 * 128 * CAP * 2, ML_GA = ML_VT + 128 * VTP * 2;
constexpr int MC_VT = 0, MC_GA = 128 * VTP * 2;
static_assert(ML_GA + 4096 <= RING_BYTES, "mlstm LDS");
__device__ __forceinline__ void mlstm_vt_ones(Frame& F, LAS bf16* VT) {
    for (int idx = F.tid; idx < 256; idx += 512) { const int t = idx >> 1, part = idx & 1;
        *(LAS v4u*)(VT + t * VTP + 160 + part * 8) = part ? (v4u){0u, 0u, 0u, 0u} : (v4u){0x3F80u, 0u, 0u, 0u}; }
}
__device__ __forceinline__ void mlstm_stageA_item(Frame& F, int item) {
    int lane = F.lane; asm volatile("" : "+v"(lane));
    const int bh = item >> 6, c = item & 63, b = bh >> 2, h = bh & 3, fr = lane & 15, fq = lane >> 4, tid = lane + 64 * F.wave;
    const size_t row0 = (size_t)b * SEQ + (size_t)c * 128;
    LAS bf16* CA = (LAS bf16*)(F.lds + ML_CA); LAS bf16* KS = (LAS bf16*)(F.lds + ML_KS); LAS bf16* VT = (LAS bf16*)(F.lds + ML_VT); LAS float* GA = (LAS float*)(F.lds + ML_GA);
    __syncthreads();
    if (F.wave == 0) {
        const float gb_i = F.in[I_GB][h], gb_f = F.in[I_GB][4 + h];
        const float* g0 = F.Gt + (row0 + 2 * lane) * 8;
        const float gi0 = g0[h] + gb_i, gf0 = g0[4 + h] + gb_f, gi1 = g0[8 + h] + gb_i, gf1 = g0[12 + h] + gb_f;
        const float lf0 = log_sigmoid(gf0), lf1 = log_sigmoid(gf1), pair = lf0 + lf1;
        float incl = pair;
#pragma unroll
        for (int o = 1; o < 64; o <<= 1) { const float t = __shfl_up(incl, o); if (lane >= o) incl += t; }
        const float a0 = (incl - pair) + lf0, a1 = incl;
        const float btot = __shfl(incl, 63);
        const float wl0 = btot - a0 + gi0, wl1 = btot - a1 + gi1;
        const float ml = wave_max(fmaxf(wl0, wl1));
        GA[2 * lane] = expf(wl0 - ml); GA[2 * lane + 1] = expf(wl1 - ml);
        if (lane == 0) { F.ML[item] = ml; F.BT[item] = btot; }
    }
    if (tid < 440) {
        const int cg = tid % 20, tg = tid / 20, t0 = 6 * tg, ch0 = h * 160 + cg * 8;
        const bf16* Zb = F.Z + (size_t)b * SEQ * ZP + ZX + ch0;
        v4u xr[9];
#pragma unroll
        for (int k = 0; k < 9; ++k) { const int tl = t0 - 3 + k, tk = c * 128 + tl; xr[k] = (tk >= 0 && tl < 128) ? *(const v4u*)(Zb + (size_t)tk * ZP) : (v4u){0u, 0u, 0u, 0u}; }
        f32x4 wa[4], wb[4];
#pragma unroll
        for (int k = 0; k < 4; ++k) { wa[k] = *(const f32x4*)(F.in[I_CW] + k * DB + ch0); wb[k] = *(const f32x4*)(F.in[I_CW] + k * DB + ch0 + 4); }
        const f32x4 ba = *(const f32x4*)(F.in[I_CB] + ch0), bb = *(const f32x4*)(F.in[I_CB] + ch0 + 4);
#pragma unroll
        for (int i = 0; i < 6; ++i) { const int t = t0 + i; if (t < 128) {
            f32x4 ya = ba, yb = bb;
#pragma unroll
            for (int k = 0; k < 4; ++k) { const v4u x = xr[i + k];
                ya[0] += wa[k][0] * bflo(x.x); ya[1] += wa[k][1] * bfhi(x.x); ya[2] += wa[k][2] * bflo(x.y); ya[3] += wa[k][3] * bfhi(x.y);
                yb[0] += wb[k][0] * bflo(x.z); yb[1] += wb[k][1] * bfhi(x.z); yb[2] += wb[k][2] * bflo(x.w); yb[3] += wb[k][3] * bfhi(x.w); }
            v4u o; o.x = pk2(siluf(ya[0]), siluf(ya[1])); o.y = pk2(siluf(ya[2]), siluf(ya[3])); o.z = pk2(siluf(yb[0]), siluf(yb[1])); o.w = pk2(siluf(yb[2]), siluf(yb[3]));
            *(LAS v4u*)(CA + t * CAP + cg * 8) = o;
            *(v4u*)(F.CAB + (row0 + t) * DB + ch0) = o;
            *(LAS v4u*)(VT + t * VTP + cg * 8) = xr[i + 3]; } }
    }
    mlstm_vt_ones(F, VT);
    __syncthreads();
    {
        const int ntile = F.wave < 4 ? 3 : 2;
        bf16x8 wf[3][5];
#pragma unroll
        for (int j = 0; j < 3; ++j) { const int ti = F.wave + 8 * (j < ntile ? j : 0); const bf16* wb_ = (ti >= 10 ? F.WK : F.WQ) + (size_t)h * 25600 + (size_t)((ti % 10) * 16 + fr) * 160 + 8 * fq;
#pragma unroll
            for (int kk = 0; kk < 5; ++kk) wf[j][kk] = *(const bf16x8*)(wb_ + 32 * kk); }
#pragma unroll
        for (int j = 0; j < 3; ++j) { if (j < ntile) { const int ti = F.wave + 8 * j; const bool isk = ti >= 10; const int e0 = (ti % 10) * 16 + 4 * fq;
            for (int tt = 0; tt < 8; ++tt) { const int t = 16 * tt + fr;
                f32x4 acc = {0.f, 0.f, 0.f, 0.f};
#pragma unroll
                for (int kk = 0; kk < 5; ++kk) acc = MFMA16(wf[j][kk], *(const LAS bf16x8*)(CA + t * CAP + 32 * kk + 8 * fq), acc);
                v2u w; w.x = pk2(acc[0], acc[1]); w.y = pk2(acc[2], acc[3]);
                if (!isk) *(v2u*)(F.QB + (row0 + t) * DB + h * 160 + e0) = w;
                else { *(v2u*)(F.KB + (row0 + t) * DB + h * 160 + e0) = w; const float wk = GA[t];
                       v2u ws; ws.x = pk2(acc[0] * wk, acc[1] * wk); ws.y = pk2(acc[2] * wk, acc[3] * wk); *(LAS v2u*)(KS + t * CAP + e0) = ws; } } } }
    }
    __syncthreads();
    for (int tix = F.wave; tix < 110; tix += 8) { const int vt = tix / 10, et = tix - vt * 10;
        f32x4 acc = {0.f, 0.f, 0.f, 0.f};
        const LAS bf16* ap = VT + (8 * fq + (fr >> 2)) * VTP + vt * 16 + 4 * (fr & 3);
        const LAS bf16* bp = KS + (8 * fq + (fr >> 2)) * CAP + et * 16 + 4 * (fr & 3);
#pragma unroll
        for (int ks = 0; ks < 4; ++ks) { const bf16x8 a = cat8(tr_read(ap + 32 * ks * VTP), tr_read(ap + (32 * ks + 4) * VTP));
                                         const bf16x8 bq = cat8(tr_read(bp + 32 * ks * CAP), tr_read(bp + (32 * ks + 4) * CAP)); acc = MFMA16(a, bq, acc); }
        float* dp = F.DC + ((size_t)item * 161 + vt * 16 + 4 * fq) * 160 + et * 16 + fr;
#pragma unroll
        for (int r = 0; r < 4; ++r) if (vt * 16 + 4 * fq + r <= 160) dp[r * 160] = acc[r];
    }
}
__device__ __forceinline__ void mlstm_scan(Frame& F, int rank, int nwg) {
    LAS float* SA = (LAS float*)F.lds; LAS float* SB = SA + 512; LAS float* SM = SA + 1024;
    __syncthreads();
    for (int idx = F.tid; idx < 512; idx += 512) { SA[idx] = F.BT[idx]; SB[idx] = F.ML[idx]; }
    __syncthreads();
    if (F.tid < 8) { const int chain = F.tid; float m = 0.f;
        for (int c = 0; c < 64; ++c) { const float bt = SA[chain * 64 + c], ml = SB[chain * 64 + c], mn = fmaxf(bt + m, ml);
            SM[chain * 64 + c] = m; SA[chain * 64 + c] = expf(bt + m - mn); SB[chain * 64 + c] = expf(ml - mn); m = mn; }
        SM[512 + chain] = m; }
    __syncthreads();
    if (rank == 0) { F.MS[F.tid] = SM[F.tid]; if (F.tid < 8) F.out[O_PM + F.tid] = SM[512 + F.tid]; }
    const int gt = rank * 512 + F.tid, NT = nwg * 512;
    for (int ec = gt; ec < 8 * 25760; ec += NT) { const int chain = ec / 25760, el = ec - chain * 25760;
        float C = 0.f;
        const float* dc = F.DC + (size_t)chain * 64 * 25760 + el; bf16* cs = F.CS + (size_t)chain * 64 * 28160 + el;
        for (int c0 = 0; c0 < 64; c0 += 16) { float d[16];
#pragma unroll
            for (int j = 0; j < 16; ++j) d[j] = __builtin_nontemporal_load(dc + (size_t)(c0 + j) * 25760);
#pragma unroll
            for (int j = 0; j < 16; ++j) { cs[(size_t)(c0 + j) * 28160] = (bf16)(pk2(C, 0.f) & 0xffffu); C = SA[chain * 64 + c0 + j] * C + SB[chain * 64 + c0 + j] * d[j]; } }
        if (el < 25600) F.out[O_PC + (size_t)chain * 25600 + el] = C; else F.out[O_PN + (size_t)chain * 160 + (el - 25600)] = C;
    }
    __syncthreads();
}
__device__ __forceinline__ void mlstm_stageC_item(Frame& F, int item, bool flip) {
    int lane = F.lane; asm volatile("" : "+v"(lane));
    const int bh = item >> 6, c = item & 63, b = bh >> 2, h = bh & 3, fr = lane & 15, fq = lane >> 4, tid = lane + 64 * F.wave;
    const size_t row0 = (size_t)b * SEQ + (size_t)c * 128;
    LAS bf16* VT = (LAS bf16*)(F.lds + MC_VT);
    LAS float* GU = (LAS float*)(F.lds + MC_GA); LAS float* GM = GU + 128; LAS float* GW = GU + 256; LAS float* GE = GU + 384;
    __syncthreads();
    if (F.wave == 0) {
        const float gb_i = F.in[I_GB][h], gb_f = F.in[I_GB][4 + h], mprev = F.MS[item];
        const float* g0 = F.Gt + (row0 + 2 * lane) * 8;
        const float gi0 = g0[h] + gb_i, gf0 = g0[4 + h] + gb_f, gi1 = g0[8 + h] + gb_i, gf1 = g0[12 + h] + gb_f;
        const float lf0 = log_sigmoid(gf0), lf1 = log_sigmoid(gf1), pair = lf0 + lf1;
        float incl = pair;
#pragma unroll
        for (int o = 1; o < 64; o <<= 1) { const float t = __shfl_up(incl, o); if (lane >= o) incl += t; }
        const float a0 = (incl - pair) + lf0, a1 = incl;
        const float u0 = gi0 - a0, u1 = gi1 - a1;
        float pm = fmaxf(u0, u1);
#pragma unroll
        for (int o = 1; o < 64; o <<= 1) { const float t = __shfl_up(pm, o); if (lane >= o) pm = fmaxf(pm, t); }
        float pe = __shfl_up(pm, 1); if (lane == 0) pe = -1e30f;
        const float M0 = fmaxf(mprev, fmaxf(pe, u0)), M1 = fmaxf(mprev, pm);
        GU[2 * lane] = u0; GU[2 * lane + 1] = u1; GM[2 * lane] = M0; GM[2 * lane + 1] = M1;
        GW[2 * lane] = expf(mprev - M0); GW[2 * lane + 1] = expf(mprev - M1);
        GE[2 * lane] = expf(-(a0 + M0)); GE[2 * lane + 1] = expf(-(a1 + M1));
    }
    {
        v4u xv[5];
#pragma unroll
        for (int j = 0; j < 5; ++j) { const int idx = tid + 512 * j, t = idx / 20, cg = idx - t * 20; xv[j] = *(const v4u*)(F.Z + (row0 + t) * ZP + ZX + h * 160 + cg * 8); }
#pragma unroll
        for (int j = 0; j < 5; ++j) { const int idx = tid + 512 * j, t = idx / 20, cg = idx - t * 20; *(LAS v4u*)(VT + t * VTP + cg * 8) = xv[j]; }
    }
    mlstm_vt_ones(F, VT);
    __syncthreads();
    const int tw = flip ? 7 - F.wave : F.wave, t0 = 16 * tw, tq = t0 + fr;
    const size_t row = row0 + tq;
    bf16x8 qf[5];
#pragma unroll
    for (int kk = 0; kk < 5; ++kk) qf[kk] = *(const bf16x8*)(F.QB + row * DB + h * 160 + 32 * kk + 8 * fq);
    f32x4 acc[11];
    const float wst = GW[tq], Mt = GM[tq], en = GE[tq];
    {
        const bf16* cs = F.CS + (size_t)item * 28160 + (size_t)fr * 160 + 8 * fq;
#pragma unroll
        for (int vt = 0; vt < 11; ++vt) { f32x4 a = {0.f, 0.f, 0.f, 0.f};
#pragma unroll
            for (int kk = 0; kk < 5; ++kk) a = MFMA16(*(const bf16x8*)(cs + vt * 16 * 160 + 32 * kk), qf[kk], a);
            acc[vt] = a * wst; }
    }
    const int npair = (tw >> 1) + 1;
    const bf16* kbase = F.KB + (row0 + fr) * DB + h * 160 + 8 * fq;
    bf16x8 ka[5], kb[5];
#pragma unroll
    for (int kk = 0; kk < 5; ++kk) { ka[kk] = *(const bf16x8*)(kbase + 32 * kk); kb[kk] = *(const bf16x8*)(kbase + (size_t)16 * DB + 32 * kk); }
    for (int i = 0; i < npair; ++i) {
        bf16x8 na[5], nb[5];
        const bool more = i + 1 < npair;
        if (more) {
#pragma unroll
            for (int kk = 0; kk < 5; ++kk) { na[kk] = *(const bf16x8*)(kbase + (size_t)(32 * (i + 1)) * DB + 32 * kk); nb[kk] = *(const bf16x8*)(kbase + (size_t)(32 * (i + 1) + 16) * DB + 32 * kk); } }
        f32x4 sa = {0.f, 0.f, 0.f, 0.f}, sb = sa;
#pragma unroll
        for (int kk = 0; kk < 5; ++kk) { sa = MFMA16(ka[kk], qf[kk], sa); sb = MFMA16(kb[kk], qf[kk], sb); }
        const f32x4 ua = *(const LAS f32x4*)(GU + 32 * i + 4 * fq), ub = *(const LAS f32x4*)(GU + 32 * i + 16 + 4 * fq);
        float pa[4], pb[4];
#pragma unroll
        for (int r = 0; r < 4; ++r) { const int s0 = 32 * i + 4 * fq + r, s1 = s0 + 16;
            pa[r] = s0 <= tq ? sa[r] * __expf(ua[r] - Mt) : 0.f; pb[r] = s1 <= tq ? sb[r] * __expf(ub[r] - Mt) : 0.f; }
        v4u pw; pw.x = pk2(pa[0], pa[1]); pw.y = pk2(pa[2], pa[3]); pw.z = pk2(pb[0], pb[1]); pw.w = pk2(pb[2], pb[3]);
        const bf16x8 pf = __builtin_bit_cast(bf16x8, pw);
        const LAS bf16* vp = VT + (32 * i + 4 * fq + (fr >> 2)) * VTP + 4 * (fr & 3);
#pragma unroll
        for (int vt = 0; vt < 11; ++vt) { const bf16x8 a = cat8(tr_read(vp + vt * 16), tr_read(vp + 16 * VTP + vt * 16)); acc[vt] = MFMA16(a, pf, acc[vt]); }
        if (more) {
#pragma unroll
            for (int kk = 0; kk < 5; ++kk) { ka[kk] = na[kk]; kb[kk] = nb[kk]; } }
    }
    const float den = __shfl(acc[10][0], fr);
    const float inv = 1.0f / fmaxf(fabsf(den), en);
    float ss = 0.f;
#pragma unroll
    for (int vt = 0; vt < 10; ++vt) { acc[vt] = acc[vt] * inv; ss += (acc[vt][0] * acc[vt][0] + acc[vt][1] * acc[vt][1]) + (acc[vt][2] * acc[vt][2] + acc[vt][3] * acc[vt][3]); }
    ss += __shfl_xor(ss, 16); ss += __shfl_xor(ss, 32);
    const float rs = 1.0f / sqrtf(ss * (1.0f / 160.0f) + EPS);
#pragma unroll
    for (int vt = 0; vt < 10; ++vt) { const int ch = h * 160 + vt * 16 + 4 * fq;
        const v2u caw = *(const v2u*)(F.CAB + row * DB + ch);
        const v2u obw = *(const v2u*)(F.Z + row * ZP + ZO + ch);
        const f32x4 ca = {bflo(caw.x), bfhi(caw.x), bflo(caw.y), bfhi(caw.y)};
        const f32x4 ob = {bflo(obw.x), bfhi(obw.x), bflo(obw.y), bfhi(obw.y)};
        const f32x4 mg = *(const f32x4*)(F.in[I_MHG] + ch), sk = *(const f32x4*)(F.in[I_SKIP] + ch);
        float o[4];
#pragma unroll
        for (int e = 0; e < 4; ++e) o[e] = sigmoidf(ob[e]) * (acc[vt][e] * rs * mg[e] + sk[e] * ca[e]);
        v2u w; w.x = pk2(o[0], o[1]); w.y = pk2(o[2], o[3]);
        *(v2u*)(F.CAT + row * DM + DA + ch) = w; }
}
__device__ __forceinline__ void attn_combine_rows2(Frame& F, int rowa, int rowb) {
    const int lane = F.lane;
    float la[2][18], av[2][18];
#pragma unroll
    for (int q = 0; q < 2; ++q) { const int row = q ? rowb : rowa;
#pragma unroll
        for (int g = 0; g < 3; ++g)
#pragma unroll
            for (int h = 0; h < 6; ++h) { la[q][g * 6 + h] = F.LSE[((size_t)g * MP + row) * 6 + h]; av[q][g * 6 + h] = bf2f(F.AO[((size_t)g * MP + row) * DA + h * 64 + lane]); } }
#pragma unroll
    for (int q = 0; q < 2; ++q) { const int row = q ? rowb : rowa;
        float o[6]; float ss = 0.f;
#pragma unroll
        for (int h = 0; h < 6; ++h) { const float l0 = la[q][h], l1 = la[q][6 + h], l2 = la[q][12 + h];
            const float mx = fmaxf(l0, fmaxf(l1, l2)), e0 = __expf(l0 - mx), e1 = __expf(l1 - mx), e2 = __expf(l2 - mx), inv = 1.0f / (e0 + e1 + e2);
            o[h] = (e0 * av[q][h] + e1 * av[q][6 + h] + e2 * av[q][12 + h]) * inv; ss += o[h] * o[h]; }
        ss = wave_sum(ss);
        const float rstd = 1.0f / sqrtf(ss * (1.0f / 384.0f) + EPS);
#pragma unroll
        for (int h = 0; h < 6; ++h) F.CAT[(size_t)row * DM + h * 64 + lane] = (bf16)(pk2(o[h] * rstd * F.in[I_AOG][h * 64 + lane], 0.f) & 0xffffu); }
}
__device__ __forceinline__ void final_norm_row(Frame& F, int m) {
    float* row = m < MP ? F.out + O_YP + (size_t)m * DM : F.out + O_YS + (size_t)(m - MP) * DM;
    f32x4* xr = (f32x4*)row + F.lane; const f32x4* gr = (const f32x4*)F.in[I_FG] + F.lane;
    f32x4 v[4]; float s = 0.f;
    if (m < MP) {
#pragma unroll
        for (int j = 0; j < 4; ++j) v[j] = xr[64 * j];
    } else {
        const f32x4* x1 = (const f32x4*)(F.X1 + (size_t)m * DM) + F.lane;
#pragma unroll
        for (int j = 0; j < 4; ++j) v[j] = x1[64 * j];
#pragma unroll
        for (int ks = 0; ks < 8; ++ks) { const f32x4* sl = (const f32x4*)(F.SLAB + ((size_t)ks * NS + (m - MP)) * DM) + F.lane;
#pragma unroll
            for (int j = 0; j < 4; ++j) v[j] = v[j] + sl[64 * j]; }
    }
#pragma unroll
    for (int j = 0; j < 4; ++j) s += (v[j].x * v[j].x + v[j].y * v[j].y) + (v[j].z * v[j].z + v[j].w * v[j].w);
    const float rstd = 1.0f / sqrtf(wave_sum(s) * (1.f / DM) + EPS);
#pragma unroll
    for (int j = 0; j < 4; ++j) xr[64 * j] = v[j] * rstd * gr[64 * j];
}

struct Args { const float* in[24]; float* out; unsigned char* ws; int ph_lo, ph_hi, li, pad; };
__global__ void __launch_bounds__(NWAVES * 64, 2) mega_fwd(Args args) {
    extern __shared__ __attribute__((aligned(16))) unsigned char lds[];
    Frame F;
    F.lds = (LAS unsigned char*)lds;
    F.MISC = (volatile LAS unsigned*)(F.lds + MISC_OFF);
    F.tid = threadIdx.x; F.lane = F.tid & 63; F.wave = __builtin_amdgcn_readfirstlane(F.tid >> 6);
    F.G = gridDim.x; { const int bx = blockIdx.x; F.vcu = (F.G % 8 == 0) ? (bx % 8) * (F.G / 8) + bx / 8 : bx; }
    unsigned char* ws = args.ws; F.ws = ws; F.out = args.out;
#pragma unroll
    for (int i = 0; i < 24; ++i) F.in[i] = args.in[i];
    F.ctl = (gu32*)(ws + WS_CTL);
    F.WIN = (bf16*)(ws + WS_WIN); F.WOUT = (bf16*)(ws + WS_WOUT); F.W1 = (bf16*)(ws + WS_W1); F.W2 = (bf16*)(ws + WS_W2); F.WQ = (bf16*)(ws + WS_WQ); F.WK = (bf16*)(ws + WS_WK);
    F.XN = (bf16*)(ws + WS_XN); F.Z = (bf16*)(ws + WS_Z); F.AO = (bf16*)(ws + WS_AO); F.CS = (bf16*)(ws + WS_CS); F.CAT = (bf16*)(ws + WS_CAT); F.X1B = (bf16*)(ws + WS_X1B); F.HFF = (bf16*)(ws + WS_HFF); F.QB = (bf16*)(ws + WS_QB); F.KB = (bf16*)(ws + WS_KB); F.CAB = (bf16*)(ws + WS_CAB);
    F.Gt = (float*)(ws + WS_G); F.SS1 = (float*)(ws + WS_SS1); F.SS2 = (float*)(ws + WS_SS2); F.ML = (float*)(ws + WS_ML); F.BT = (float*)(ws + WS_BT); F.MS = (float*)(ws + WS_MS);
    F.LSE = (float*)(ws + WS_LSE); F.DC = (float*)(ws + WS_DC); F.X1 = (float*)(ws + WS_X1); F.SLAB = (float*)(ws + WS_SLAB);
    for (int u = F.tid; u < (LDS_BYTES - LDSCTL_OFF) / 4; u += NWAVES * 64) ((LAS unsigned*)(F.lds + LDSCTL_OFF))[u] = 0u;
    __syncthreads();
    XcdBarrier bar; bar.bar = (unsigned*)(F.ctl + CW_BAR); bar.x = 0; bar.st = nullptr;
    if (N_LAUNCHES != PER_PHASE) bar = xcd_barrier_post((unsigned*)(F.ctl + CW_BAR), F.MISC + 8);
#define GRID_BAR() do { if (N_LAUNCHES != PER_PHASE) { if (STEAL) xcd_barrier_steal(bar, F); else xcd_barrier(bar); } } while (0)
    int& F_tid_ref = F.tid; int& F_lane_ref = F.lane;
    const int lo = args.ph_lo, hi = args.ph_hi;
#define IN(k) (lo <= (k) && (k) < hi)
#define BOTH(k) (IN(k) && IN((k) + 1))
    const int gw = F.vcu * NWAVES + F.wave, NGW = F.G * NWAVES;

    if (IN(0)) PH(0) { p0_prologue(F); if (BOTH(0)) GRID_BAR(); }

    if (IN(1)) PH(1) {
        const int xl = (int)blockIdx.x & 7, slot = (int)blockIdx.x >> 3;
        constexpr int P1_SLOTS = 27;
        if (slot < P1_SLOTS) {
            pg8::Gemm g{F.XN, F.WIN, MP, ZP, DM}; pg8::StaticOrder S; S.init(MP, ZP, 8 * P1_SLOTS, slot * 8 + xl);
            pg8::EpiZ E{F.Z, F.Gt};
            REP(3) pg8::gemm_phase<pg8::EpiZ, pg8::StaticOrder, true, true>(F.lds, g, S, E);
        } else {
            const int cw = (slot - P1_SLOTS) * 8 + xl;
            SEpiZ SE{F.Z, F.Gt};
            for (int u = cw; u < 80; u += 8 * (32 - P1_SLOTS)) small_gemm<2, SEpiZ>(F, F.XN + (size_t)MP * DM, F.WIN, DM, 0, DM, 32 * u, SE);
        }
        if (BOTH(1)) GRID_BAR();
    }

    if (IN(2)) PH(2) {
        __syncthreads();
        LAS float* biasT = (LAS float*)(F.lds + P2_BIAS_OFF);
        build_bias_table(F, biasT);
        __syncthreads();
        { const int gt = F.vcu * 512 + F.tid, NT = F.G * 512;
          for (int idx = gt; idx < NBATCH * 2048 * (2 * DA / 8); idx += NT) { const int cg = idx % 96, rr = idx / 96, b = rr / 2048, t = rr % 2048;
              const v4u w = *(const v4u*)(F.Z + ((size_t)b * SEQ + (SEQ - 2048) + t) * ZP + ZK + cg * 8);
              const int col = cg * 8; float* dst = col < DA ? F.out + O_PWK + ((size_t)b * 2048 + t) * DA + col : F.out + O_PWV + ((size_t)b * 2048 + t) * DA + (col - DA);
              *(f32x4*)dst = (f32x4){bflo(w.x), bfhi(w.x), bflo(w.y), bfhi(w.y)}; *(f32x4*)(dst + 4) = (f32x4){bflo(w.z), bfhi(w.z), bflo(w.w), bfhi(w.w)}; }
          for (int idx = gt; idx < NBATCH * 3 * DB; idx += NT) { const int b = idx / (3 * DB), rr = (idx % (3 * DB)) / DB, ch = idx % DB;
              F.out[O_PCONV + idx] = bf2f(F.Z[((size_t)b * SEQ + (SEQ - 3) + rr) * ZP + ZX + ch]); } }
        { LAS float* obuf = (LAS float*)(F.lds + P2_VT_OFF);
          REP(4) for (int b = F.vcu; b < NS; b += F.G) attn_sample_item(F, b, biasT, obuf); }
        __syncthreads();
        { LAS bf16* vl = (LAS bf16*)(F.lds + P2_VT_OFF + F.wave * P2_VT_WAVE);
          const bool light = F.vcu < NS; const int nit = light ? 3 : 6, base = light ? gw * 3 : 3072 + (gw - NS * NWAVES) * 6;
          REP(5) for (int j = 0; j < nit; ++j) attn_prompt_item(F, base + j, vl, biasT); }
        __syncthreads();
        { LAS float* sb = (LAS float*)(F.lds);
          REP(6) for (int it = F.vcu; it < NS * HB; it += F.G) mlstm_sample_item(F, it, sb); }
        __syncthreads();
        REP(7) for (int it = F.vcu; it < 512; it += F.G) mlstm_stageA_item(F, it);
        if (BOTH(2)) GRID_BAR();
    }

    if (IN(3)) PH(3) { if (F.vcu < 16) { SEpiX1 SE{F.in[I_XS], F.X1, F.X1B, F.SS1}; small_gemm<4, SEpiX1>(F, F.CAT + (size_t)MP * DM, F.WOUT, DM, 0, DM, 64 * F.vcu, SE); }
        else { REP(8) mlstm_scan(F, F.vcu - 16, F.G - 16); }
        if (BOTH(3)) GRID_BAR(); }

    if (IN(4)) PH(4) {
        REP(9) { bool flip = false; for (int it = F.vcu; it < 512; it += F.G) { mlstm_stageC_item(F, it, flip); flip = !flip; } }
        if (F.vcu < 128) { SEpiFF1 SE{F.HFF, F.SS1}; small_gemm<2, SEpiFF1>(F, F.X1B + (size_t)MP * DM, F.W1, DM, 0, DM, 32 * F.vcu, SE); }
        else { const int w2 = gw - 128 * NWAVES; REP(10) for (int m = 2 * w2; m < MP; m += 2 * 128 * NWAVES) attn_combine_rows2(F, m, m + 1); }
        if (BOTH(4)) GRID_BAR();
    }

    if (IN(5)) PH(5) {
        __syncthreads();
        pg8::Gemm g{F.CAT, F.WOUT, MP, DM, DM}; pg8::StaticOrder S; S.init(MP, DM, F.G, (int)blockIdx.x);
        pg8::EpiX1 E{F.in[I_XP], F.in[I_XS], F.X1, F.X1B, F.SS1};
        REP(11) pg8::gemm_phase<pg8::EpiX1, pg8::StaticOrder, true, true>(F.lds, g, S, E);
        { const int u = F.vcu & 31, ks = F.vcu >> 5; if (ks < 8) { SEpiSlab SE{F.SLAB + (size_t)ks * NS * DM}; small_gemm<2, SEpiSlab>(F, F.HFF + (size_t)MP * DFF, F.W2, DFF, 512 * ks, 512 * ks + 512, 32 * u, SE); } }
        if (BOTH(5)) GRID_BAR();
    }
    if (IN(6)) PH(6) {
        const int xl = (int)blockIdx.x & 7, slot = (int)blockIdx.x >> 3;
        constexpr int P6_SLOTS = 26;
        if (slot < P6_SLOTS) {
            pg8::Gemm g{F.X1B, F.W1, MP, DFF, DM}; pg8::StaticOrder S; S.init(MP, DFF, 8 * P6_SLOTS, slot * 8 + xl);
            pg8::EpiFF1 E{F.HFF, F.SS1};
            pg8::gemm_phase<pg8::EpiFF1, pg8::StaticOrder, true, true>(F.lds, g, S, E);
        }
        if (BOTH(6)) GRID_BAR();
    }
    if (IN(7)) PH(7) {
        pg8::Gemm g{F.HFF, F.W2, MP, DM, DFF}; pg8::StaticOrder S; S.init(MP, DM, F.G, (int)blockIdx.x);
        pg8::EpiX2 E{F.X1, F.out + O_YP, F.out + O_YS, F.SS2};
        REP(13) pg8::gemm_phase<pg8::EpiX2, pg8::StaticOrder, true, true>(F.lds, g, S, E);
        if (BOTH(7)) GRID_BAR();
    }
    if (IN(8)) { REP(14) for (int m = gw; m < MT; m += NGW) final_norm_row(F, m); REP(15) copy_drain(F); }
#undef IN
#undef BOTH
}

extern "C" void kernel_launch(void* const* d_in, const int* in_sizes, int n_in, void* d_out, int out_size, void* d_ws, size_t ws_size, hipStream_t stream) {
    static int grid = 0;
    if (grid == 0) {
        if (n_in != 24 || (size_t)out_size != O_END || ws_size < WS_END) { fprintf(stderr, "kernel_launch: unexpected sizes n_in %d out %d ws %zu\n", n_in, out_size, ws_size); grid = -1; return; }
        int dev = 0, cus = 0, per_cu = 0;
        if (hipGetDevice(&dev) != hipSuccess || hipDeviceGetAttribute(&cus, hipDeviceAttributeMultiprocessorCount, dev) != hipSuccess) { grid = -1; return; }
        if (hipFuncSetAttribute((const void*)mega_fwd, hipFuncAttributeMaxDynamicSharedMemorySize, LDS_BYTES) != hipSuccess) { fprintf(stderr, "kernel_launch: hipFuncSetAttribute failed\n"); grid = -1; return; }
        if (hipOccupancyMaxActiveBlocksPerMultiprocessor(&per_cu, (const void*)mega_fwd, NWAVES * 64, LDS_BYTES) != hipSuccess || per_cu < 1) { fprintf(stderr, "kernel_launch: occupancy query says %d blocks per CU\n", per_cu); (void)hipGetLastError(); grid = -1; return; }
        grid = cus;
    }
    if (grid < 0) return;
    (void)hipMemsetAsync((char*)d_ws + WS_CTL, 0, CTL_ZERO_BYTES, stream);
    Args a{};
    for (int i = 0; i < 24; ++i) a.in[i] = (const float*)d_in[i];
    a.out = (float*)d_out; a.ws = (unsigned char*)d_ws;
    if (N_LAUNCHES == PER_PHASE) {
        for (int li = 0; li < PER_PHASE; ++li) { a.ph_lo = li; a.ph_hi = li + 1; a.li = li; hipLaunchKernelGGL(mega_fwd, dim3(grid), dim3(NWAVES * 64), LDS_BYTES, stream, a); }
    } else {
        a.ph_lo = 0; a.ph_hi = PER_PHASE; a.li = 0;
        hipLaunchKernelGGL(mega_fwd, dim3(grid), dim3(NWAVES * 64), LDS_BYTES, stream, a);
    }
}
```

```cpp
#include <hip/hip_runtime.h>
#include <cstdio>
#include <cstdint>

constexpr int DM = 1024, SEQ = 8192, NBATCH = 2, MP = NBATCH * SEQ, NS = 128, MT = MP + NS, MPAD = 16640;
constexpr int DA = 384, DB = 640, HA = 6, HB = 4, EB = 160, DIN = 2440, ZP = 2560, DFF = 4096;
constexpr int ZQ = 0, ZK = 384, ZV = 768, ZX = 1152, ZO = 1792, ZG = 2432;
constexpr int PAST = 2048, NCH = 64, LCH = 128;
constexpr float EPS = 1e-6f;

namespace pg8 {
#define PG8_LAS __attribute__((address_space(3)))
typedef unsigned short bf16_t;
typedef short bf16x8 __attribute__((ext_vector_type(8)));
typedef float f32x4 __attribute__((ext_vector_type(4)));
typedef unsigned u32x4 __attribute__((ext_vector_type(4)));
constexpr int BM = 256, BK = 64, HALF = 128, HTB = HALF * BK * 2  , STAGE_BYTES = 8 * HTB, NXCD = 8, WGM = 8;

__host__ __device__ __forceinline__ int lds_byte(int r, int c) { const int st = (r >> 4) * 2 + (c >> 5), rr = r & 15, cc = c & 31, ob = rr * 64 + cc * 2; return st * 1024 + (ob ^ (((ob >> 9) & 1) << 5)); }
__host__ __device__ __forceinline__ void stage_rc(int b, int& R, int& C) { const int st = b / 1024, sb = b % 1024, swz = sb ^ (((sb >> 9) & 1) << 5); R = (st >> 1) * 16 + swz / 64; C = (st & 1) * 32 + (swz % 64) / 2; }
__host__ __device__ __forceinline__ int perm32(int rho) { const int n = rho >> 4, i = rho & 15; return 8 * (i >> 2) + 4 * n + (i & 3); }

struct Unit { int pm, pn; };
struct Gemm { const bf16_t* A; const bf16_t* Bt; int M, N, K; };

struct StaticOrder {
    int nM, nN, nwg, G, c;
    __host__ __device__ void init(int M, int N, int G_, int c_) { nM = M / BM; nN = N / BM; nwg = nM * nN; G = G_; c = c_; }
    __host__ __device__ bool next(int i, Unit& u) const {
        const long L = (long)i * G + c; if (L >= nwg) return false;
        int wgid = (int)L; { const int q = nwg / NXCD, r = nwg % NXCD, xcd = wgid % NXCD, off = wgid / NXCD; wgid = (xcd < r ? xcd * (q + 1) : r * (q + 1) + (xcd - r) * q) + off; }
        const int nig = WGM * nN, gid = wgid / nig, fm = gid * WGM, gsz = (nM - fm) < WGM ? (nM - fm) : WGM;
        u.pm = fm + ((wgid % nig) % gsz); u.pn = (wgid % nig) / gsz; return true;
    }
    __device__ __forceinline__ void a_ready(const Unit&) const {}
    __device__ __forceinline__ void done(const Unit&) const {}
};


typedef float f32x2 __attribute__((ext_vector_type(2)));
typedef __bf16 bf16x2_t __attribute__((ext_vector_type(2)));
typedef unsigned u32x2 __attribute__((ext_vector_type(2)));
__device__ __forceinline__ unsigned cvt_pk_bf16(float lo, float hi) { f32x2 v = {lo, hi}; bf16x2_t b = __builtin_convertvector(v, bf16x2_t); return __builtin_bit_cast(unsigned, b); }

struct EpiZ {
    static constexpr bool PERM = true, AFTER_DRAIN = false;
    bf16_t* Z; float* G;
    __device__ __forceinline__ void operator()(const f32x4 (&acc)[2][2][4][2], const Unit& u, int wr, int wc, int fr, int fq) const {
        const int row0 = u.pm * BM + wr * 64 + fr, col0 = u.pn * BM + wc * 32 + 8 * fq;
        const bool gates = (u.pn == 9) && (wc == 0) && (fq == 0);
#pragma unroll
        for (int ai = 0; ai < 2; ++ai)
#pragma unroll
            for (int m = 0; m < 4; ++m) { const int row = row0 + ai * HALF + m * 16; bf16_t* rowp = Z + (size_t)row * 2560 + col0;
#pragma unroll
                for (int bj = 0; bj < 2; ++bj) { const f32x4 v0 = acc[ai][bj][m][0], v1 = acc[ai][bj][m][1];
                    u32x4 w; w.x = cvt_pk_bf16(v0[0], v0[1]); w.y = cvt_pk_bf16(v0[2], v0[3]); w.z = cvt_pk_bf16(v1[0], v1[1]); w.w = cvt_pk_bf16(v1[2], v1[3]);
                    *(u32x4*)(rowp + bj * HALF) = w; }
                if (gates) { *(f32x4*)(G + (size_t)row * 8) = acc[ai][1][m][0]; *(f32x4*)(G + (size_t)row * 8 + 4) = acc[ai][1][m][1]; } }
    }
};
struct EpiX1 {
    static constexpr bool PERM = false, AFTER_DRAIN = false;
    const float* xp; const float* xs; float* X1; bf16_t* X1B; float* SS;
    __device__ __forceinline__ void operator()(const f32x4 (&acc)[2][2][4][2], const Unit& u, int wr, int wc, int fr, int fq) const {
        const int row0 = u.pm * BM + wr * 64 + fr, col0 = u.pn * BM + wc * 32 + 4 * fq;
#pragma unroll
        for (int ai = 0; ai < 2; ++ai)
#pragma unroll
            for (int m = 0; m < 4; ++m) { const int row = row0 + ai * HALF + m * 16;
                const float* xr = row < 16384 ? xp + (size_t)row * 1024 : (row < 16512 ? xs + (size_t)(row - 16384) * 1024 : nullptr);
                float ss = 0.f;
#pragma unroll
                for (int bj = 0; bj < 2; ++bj)
#pragma unroll
                    for (int n = 0; n < 2; ++n) { const int col = col0 + bj * HALF + n * 16;
                        f32x4 xv = {0.f, 0.f, 0.f, 0.f}; if (xr) xv = *(const f32x4*)(xr + col);
                        const f32x4 v = acc[ai][bj][m][n] + xv;
                        *(f32x4*)(X1 + (size_t)row * 1024 + col) = v;
                        u32x2 w; w.x = cvt_pk_bf16(v[0], v[1]); w.y = cvt_pk_bf16(v[2], v[3]); *(u32x2*)(X1B + (size_t)row * 1024 + col) = w;
                        ss += (v[0] * v[0] + v[1] * v[1]) + (v[2] * v[2] + v[3] * v[3]); }
                ss += __shfl_xor(ss, 16); ss += __shfl_xor(ss, 32);
                if (fq == 0) SS[(size_t)row * 16 + u.pn * 4 + wc] = ss; }
    }
};
struct EpiFF1 {
    static constexpr bool PERM = true, AFTER_DRAIN = false;
    bf16_t* H; const float* SS;
    __device__ __forceinline__ void operator()(const f32x4 (&acc)[2][2][4][2], const Unit& u, int wr, int wc, int fr, int fq) const {
        const int row0 = u.pm * BM + wr * 64 + fr, col0 = u.pn * BM + wc * 32 + 8 * fq;
#pragma unroll
        for (int ai = 0; ai < 2; ++ai)
#pragma unroll
            for (int m = 0; m < 4; ++m) { const int row = row0 + ai * HALF + m * 16;
                const f32x4* sp = (const f32x4*)(SS + (size_t)row * 16); const f32x4 s0 = sp[0], s1 = sp[1], s2 = sp[2], s3 = sp[3];
                const float tot = ((s0[0] + s0[1]) + (s0[2] + s0[3])) + ((s1[0] + s1[1]) + (s1[2] + s1[3])) + ((s2[0] + s2[1]) + (s2[2] + s2[3])) + ((s3[0] + s3[1]) + (s3[2] + s3[3]));
                const float rstd = 1.0f / sqrtf(tot * (1.0f / 1024.0f) + 1e-6f);
                bf16_t* rowp = H + (size_t)row * 4096 + col0;
#pragma unroll
                for (int bj = 0; bj < 2; ++bj) { f32x4 v0 = acc[ai][bj][m][0] * rstd, v1 = acc[ai][bj][m][1] * rstd;
#pragma unroll
                    for (int e = 0; e < 4; ++e) { const float a = fmaxf(v0[e], 0.f), b = fmaxf(v1[e], 0.f); v0[e] = a * a; v1[e] = b * b; }
                    u32x4 w; w.x = cvt_pk_bf16(v0[0], v0[1]); w.y = cvt_pk_bf16(v0[2], v0[3]); w.z = cvt_pk_bf16(v1[0], v1[1]); w.w = cvt_pk_bf16(v1[2], v1[3]);
                    *(u32x4*)(rowp + bj * HALF) = w; } }
    }
};
struct EpiX2 {
    static constexpr bool PERM = false, AFTER_DRAIN = false;
    const float* X1; float* yp; float* ys; float* SS;
    __device__ __forceinline__ void operator()(const f32x4 (&acc)[2][2][4][2], const Unit& u, int wr, int wc, int fr, int fq) const {
        const int row0 = u.pm * BM + wr * 64 + fr, col0 = u.pn * BM + wc * 32 + 4 * fq;
#pragma unroll
        for (int ai = 0; ai < 2; ++ai)
#pragma unroll
            for (int m = 0; m < 4; ++m) { const int row = row0 + ai * HALF + m * 16;
                float* orow = row < 16384 ? yp + (size_t)row * 1024 : (row < 16512 ? ys + (size_t)(row - 16384) * 1024 : nullptr);
                float ss = 0.f;
#pragma unroll
                for (int bj = 0; bj < 2; ++bj)
#pragma unroll
                    for (int n = 0; n < 2; ++n) { const int col = col0 + bj * HALF + n * 16;
                        const f32x4 v = acc[ai][bj][m][n] + *(const f32x4*)(X1 + (size_t)row * 1024 + col);
                        if (orow) *(f32x4*)(orow + col) = v;
                        ss += (v[0] * v[0] + v[1] * v[1]) + (v[2] * v[2] + v[3] * v[3]); }
                ss += __shfl_xor(ss, 16); ss += __shfl_xor(ss, 32);
                if (fq == 0) SS[(size_t)row * 16 + u.pn * 4 + wc] = ss; }
    }
};

template <class Epi, class Sched, bool ALIGN_EPI = false, bool SP2 = false>
__device__ __forceinline__ void gemm_phase(PG8_LAS unsigned char* lds, const Gemm g, const Sched& S, const Epi& E) {
    const int tid = threadIdx.x, wid = __builtin_amdgcn_readfirstlane(tid >> 6), lane = tid & 63, wr = wid >> 2, wc = wid & 3, fr = lane & 15, fq = lane >> 4;
    const int K = g.K, nt = K / BK;
    unsigned voffA[2], voffB[2];
#pragma unroll
    for (int i = 0; i < 2; ++i) { int R, C; stage_rc(tid * 16 + i * 8192, R, C); const int Rb = Epi::PERM ? ((R & ~31) + perm32(R & 31)) : R;
        voffA[i] = (unsigned)(R * K + C) * 2u; voffB[i] = (unsigned)(Rb * K + C) * 2u; }
    const size_t kstep = (size_t)(BK * 2);
    const size_t hstep = (size_t)HALF * K * 2;
    const size_t tstep = 2 * hstep;
    const unsigned ldsw = (unsigned)wid * 1024u;
    const int aoff = lds_byte(wr * 64 + fr, fq * 8), boff = lds_byte(wc * 32 + fr, fq * 8);
#define PG8_SA(b, h) (((b) * 2 + (h)) * HTB)
#define PG8_SB(b, h) ((4 + (b) * 2 + (h)) * HTB)
#define PG8_STAGE(bufoff, gbase, voff) do { _Pragma("unroll") for (int _i = 0; _i < 2; ++_i) \
        __builtin_amdgcn_global_load_lds((const unsigned*)((const char*)(gbase) + (voff)[_i]), (PG8_LAS unsigned*)(lds + (bufoff) + ldsw + _i * 8192), 16, 0, 0); } while (0)
#define PG8_LDA(dst, b, h) do { _Pragma("unroll") for (int m = 0; m < 4; ++m) _Pragma("unroll") for (int k = 0; k < 2; ++k) dst[m][k] = *(const PG8_LAS bf16x8*)(lds + PG8_SA(b, h) + aoff + m * 2048 + k * 1024); } while (0)
#define PG8_LDB(dst, b, h) do { _Pragma("unroll") for (int n = 0; n < 2; ++n) _Pragma("unroll") for (int k = 0; k < 2; ++k) dst[n][k] = *(const PG8_LAS bf16x8*)(lds + PG8_SB(b, h) + boff + n * 2048 + k * 1024); } while (0)
#define PG8_MMA(ai, bj, At, Bt) do { __builtin_amdgcn_s_setprio(1); _Pragma("unroll") for (int m = 0; m < 4; ++m) _Pragma("unroll") for (int n = 0; n < 2; ++n) _Pragma("unroll") for (int k = 0; k < 2; ++k) \
        acc[ai][bj][m][n] = __builtin_amdgcn_mfma_f32_16x16x32_bf16(Bt[n][k], At[m][k], acc[ai][bj][m][n], 0, 0, 0); __builtin_amdgcn_s_setprio(0); } while (0)
#define PG8_WAIT_V(n) asm volatile("s_waitcnt vmcnt(" #n ")" ::: "memory")
#define PG8_WAIT_L(n) asm volatile("s_waitcnt lgkmcnt(" #n ")" ::: "memory")
#define PG8_BAR __builtin_amdgcn_s_barrier()
#define PG8_SCHED __builtin_amdgcn_sched_barrier(0)
    Unit cur, nxt; int ui = 0;
    if (!S.next(0, cur)) return;
    f32x4 acc[2][2][4][2];
#pragma unroll
    for (int a = 0; a < 2; ++a)
#pragma unroll
        for (int b = 0; b < 2; ++b)
#pragma unroll
            for (int m = 0; m < 4; ++m)
#pragma unroll
                for (int n = 0; n < 2; ++n) acc[a][b][m][n] = (f32x4){0.f, 0.f, 0.f, 0.f};
    bf16x8 At[4][2], B0[2][2], B1[2][2];
    const char* cA = (const char*)g.A + (size_t)cur.pm * tstep; const char* cB = (const char*)g.Bt + (size_t)cur.pn * tstep;
    S.a_ready(cur);
    if constexpr (SP2) {
        PG8_STAGE(PG8_SB(0, 0), cB, voffB); PG8_STAGE(PG8_SB(0, 1), cB + hstep, voffB); PG8_STAGE(PG8_SA(0, 0), cA, voffA); PG8_STAGE(PG8_SA(0, 1), cA + hstep, voffA);
        if (wr == 1) PG8_BAR;
        PG8_WAIT_V(2); PG8_BAR;
        PG8_STAGE(PG8_SB(1, 0), cB + kstep, voffB); PG8_STAGE(PG8_SA(1, 0), cA + kstep, voffA); PG8_STAGE(PG8_SB(1, 1), cB + hstep + kstep, voffB);
        PG8_WAIT_V(6); PG8_BAR;
    } else {
        PG8_STAGE(PG8_SB(0, 0), cB, voffB); PG8_STAGE(PG8_SA(0, 0), cA, voffA); PG8_STAGE(PG8_SB(0, 1), cB + hstep, voffB); PG8_STAGE(PG8_SA(0, 1), cA + hstep, voffA);
        if (wr == 1) PG8_BAR;
        PG8_WAIT_V(4); PG8_BAR;
        PG8_STAGE(PG8_SB(1, 0), cB + kstep, voffB); PG8_STAGE(PG8_SA(1, 0), cA + kstep, voffA); PG8_STAGE(PG8_SB(1, 1), cB + hstep + kstep, voffB);
        PG8_WAIT_V(6); PG8_BAR;
    }
    for (;;) {
        const bool has_next = S.next(ui + 1, nxt);
        const char* nA = has_next ? (const char*)g.A + (size_t)nxt.pm * tstep : cA; const char* nB = has_next ? (const char*)g.Bt + (size_t)nxt.pn * tstep : cB;
        for (int t = 0; t < nt; t += 2) {
            const bool last = (t == nt - 2);
            const char* a1 = cA + (size_t)(t + 1) * kstep;
            const char* a2 = last ? nA : cA + (size_t)(t + 2) * kstep; const char* b2 = last ? nB : cB + (size_t)(t + 2) * kstep;
            const char* a3 = a2 + kstep; const char* b3 = b2 + kstep;
            if (last && has_next) S.a_ready(nxt);
            if constexpr (SP2) {
            PG8_LDB(B0, 0, 0); PG8_LDB(B1, 0, 1); PG8_SCHED; PG8_LDA(At, 0, 0); PG8_STAGE(PG8_SA(1, 1), a1 + hstep, voffA);
            PG8_WAIT_V(8); PG8_WAIT_L(0); PG8_BAR; PG8_MMA(0, 0, At, B0); PG8_MMA(0, 1, At, B1); PG8_BAR; PG8_SCHED;
            PG8_LDA(At, 0, 1); PG8_STAGE(PG8_SB(0, 0), b2, voffB); PG8_STAGE(PG8_SB(0, 1), b2 + hstep, voffB); PG8_STAGE(PG8_SA(0, 0), a2, voffA);
            PG8_WAIT_V(8); PG8_WAIT_L(0); PG8_BAR; PG8_MMA(1, 0, At, B0); PG8_MMA(1, 1, At, B1); PG8_BAR; PG8_SCHED;
            PG8_LDB(B0, 1, 0); PG8_LDB(B1, 1, 1); PG8_SCHED; PG8_LDA(At, 1, 0); PG8_STAGE(PG8_SA(0, 1), a2 + hstep, voffA);
            PG8_WAIT_V(8); PG8_WAIT_L(0); PG8_BAR; PG8_MMA(0, 0, At, B0); PG8_MMA(0, 1, At, B1); PG8_BAR; PG8_SCHED;
            PG8_LDA(At, 1, 1); PG8_STAGE(PG8_SB(1, 0), b3, voffB); PG8_STAGE(PG8_SB(1, 1), b3 + hstep, voffB); PG8_STAGE(PG8_SA(1, 0), a3, voffA);
            PG8_WAIT_V(8); PG8_WAIT_L(0); PG8_BAR; PG8_MMA(1, 0, At, B0); PG8_MMA(1, 1, At, B1); PG8_BAR; PG8_SCHED;
            } else {
            PG8_LDB(B0, 0, 0); PG8_SCHED; PG8_LDA(At, 0, 0); PG8_STAGE(PG8_SA(1, 1), a1 + hstep, voffA);
            PG8_WAIT_L(8); PG8_BAR; PG8_WAIT_L(0); PG8_MMA(0, 0, At, B0); PG8_BAR; PG8_SCHED;
            PG8_LDB(B1, 0, 1); PG8_STAGE(PG8_SB(0, 0), b2, voffB);
            PG8_BAR; PG8_WAIT_L(0); PG8_MMA(0, 1, At, B1); PG8_BAR;
            PG8_LDA(At, 0, 1); PG8_STAGE(PG8_SA(0, 0), a2, voffA);
            PG8_BAR; PG8_WAIT_L(0); PG8_MMA(1, 0, At, B0); PG8_BAR; PG8_SCHED;
            PG8_STAGE(PG8_SB(0, 1), b2 + hstep, voffB);
            PG8_WAIT_V(6); PG8_BAR; PG8_MMA(1, 1, At, B1); PG8_BAR;
            PG8_LDB(B0, 1, 0); PG8_SCHED; PG8_LDA(At, 1, 0); PG8_STAGE(PG8_SA(0, 1), a2 + hstep, voffA);
            PG8_WAIT_L(8); PG8_BAR; PG8_WAIT_L(0); PG8_MMA(0, 0, At, B0); PG8_BAR; PG8_SCHED;
            PG8_LDB(B1, 1, 1); PG8_STAGE(PG8_SB(1, 0), b3, voffB);
            PG8_BAR; PG8_WAIT_L(0); PG8_MMA(0, 1, At, B1); PG8_BAR;
            PG8_LDA(At, 1, 1); PG8_STAGE(PG8_SA(1, 0), a3, voffA);
            PG8_BAR; PG8_WAIT_L(0); PG8_MMA(1, 0, At, B0); PG8_BAR; PG8_SCHED;
            PG8_STAGE(PG8_SB(1, 1), b3 + hstep, voffB);
            PG8_WAIT_V(6); PG8_BAR; PG8_MMA(1, 1, At, B1); PG8_BAR;
            }
        }
        if constexpr (ALIGN_EPI) { if (wr == 0) PG8_BAR; }
        if constexpr (!Epi::AFTER_DRAIN) { E(acc, cur, wr, wc, fr, fq); S.done(cur); }
        if (!has_next) break;
#pragma unroll
        for (int a = 0; a < 2; ++a)
#pragma unroll
            for (int b = 0; b < 2; ++b)
#pragma unroll
                for (int m = 0; m < 4; ++m)
#pragma unroll
                    for (int n = 0; n < 2; ++n) acc[a][b][m][n] = (f32x4){0.f, 0.f, 0.f, 0.f};
        cur = nxt; cA = nA; cB = nB; ++ui;
        if constexpr (ALIGN_EPI) { if (wr == 1) PG8_BAR; }
    }
    PG8_WAIT_V(0);
    if constexpr (!ALIGN_EPI) { if (wr == 0) PG8_BAR; }
    PG8_BAR;
    if constexpr (Epi::AFTER_DRAIN) { E.fused(acc, cur, wr, wc, fr, fq, lds, wid, lane); S.done(cur); }
#undef PG8_SA
#undef PG8_SB
#undef PG8_STAGE
#undef PG8_LDA
#undef PG8_LDB
#undef PG8_MMA
#undef PG8_WAIT_V
#undef PG8_WAIT_L
#undef PG8_BAR
#undef PG8_SCHED
}
}


#ifndef DUP_ID
#define DUP_ID 0
#endif
#ifndef DUP_N
#define DUP_N 2
#endif
#ifndef STEAL
#define STEAL 1
#endif
__device__ __forceinline__ bool launder_lane(int& a, int& b) { asm volatile("" : "+v"(a), "+v"(b)); return true; }
#define PH(k) for (int ph_ = 0; ph_ < (DUP_ID == 100 + (k) ? 1 + DUP_N : 1) && launder_lane(F_tid_ref, F_lane_ref); ++ph_)
#define REP(id) for (int rep_ = 0; rep_ < (DUP_ID == (id) ? 1 + DUP_N : 1); ++rep_)
#ifndef MK_N_LAUNCHES
#define MK_N_LAUNCHES 1
#endif
constexpr int NWAVES = 8;
constexpr int PER_PHASE = 9;
constexpr int N_LAUNCHES = MK_N_LAUNCHES;

constexpr size_t MiB = 1u << 20;
constexpr size_t WS_CTL = 0, CTL_ZERO_BYTES = 1 * MiB;
constexpr size_t WS_WIN = 2 * MiB, WS_WOUT = 7 * MiB, WS_W1 = 9 * MiB, WS_W2 = 17 * MiB, WS_WQ = 25 * MiB, WS_WK = 25 * MiB + 256 * 1024;
constexpr size_t WS_SLAB = 526 * MiB;
constexpr size_t WS_QB = 530 * MiB, WS_KB = 551 * MiB, WS_CAB = 572 * MiB;
constexpr size_t WS_G = 26 * MiB, WS_SS1 = 27 * MiB, WS_SS2 = 29 * MiB, WS_ML = 31 * MiB, WS_BT = 31 * MiB + 4096, WS_MS = 31 * MiB + 8192;
constexpr size_t WS_LSE = 32 * MiB, WS_XN = 34 * MiB, WS_Z = 67 * MiB, WS_AO = 149 * MiB, WS_DC = 185 * MiB, WS_CS = 236 * MiB, WS_CAT = 264 * MiB;
constexpr size_t WS_X1 = 297 * MiB, WS_X1B = 362 * MiB, WS_HFF = 395 * MiB, WS_END = 593 * MiB;
static_assert(WS_XN + (size_t)MPAD * DM * 2 <= WS_Z && WS_Z + (size_t)MPAD * ZP * 2 <= WS_AO && WS_AO + (size_t)3 * MP * DA * 2 <= WS_DC, "ws map 1");
static_assert(WS_DC + (size_t)512 * 161 * 160 * 4 <= WS_CS && WS_CS + (size_t)512 * 176 * 160 * 2 <= WS_CAT && WS_CAT + (size_t)MPAD * DM * 2 <= WS_X1, "ws map 2");
static_assert(WS_X1 + (size_t)MPAD * DM * 4 <= WS_X1B && WS_X1B + (size_t)MPAD * DM * 2 <= WS_HFF && WS_HFF + (size_t)MPAD * DFF * 2 <= WS_SLAB, "ws map 3");
static_assert(WS_SS1 + (size_t)MPAD * 16 * 4 <= WS_SS2 && WS_SS2 + (size_t)MPAD * 16 * 4 <= WS_ML && WS_LSE + (size_t)3 * MP * 6 * 4 <= WS_XN && WS_G + (size_t)MPAD * 8 * 4 <= WS_SS1, "ws map 4");
constexpr int CW_TMO = 0, CW_COPYQ = 64, CW_BAR = 4096;
constexpr unsigned CP_BURST4 = 8192, CP_PER_SLICE = 24, CP_N4 = 2047 * DA / 4, CP_NQ = 2 * NS * CP_PER_SLICE;

constexpr size_t O_YP = 0, O_YS = O_YP + (size_t)MP * DM, O_PWK = O_YS + (size_t)NS * DM, O_PWV = O_PWK + (size_t)NBATCH * 2048 * DA, O_PCONV = O_PWV + (size_t)NBATCH * 2048 * DA;
constexpr size_t O_PC = O_PCONV + (size_t)NBATCH * 3 * DB, O_PN = O_PC + (size_t)NBATCH * HB * EB * EB, O_PM = O_PN + (size_t)NBATCH * HB * EB, O_SWK = O_PM + (size_t)NBATCH * HB;
constexpr size_t O_SWV = O_SWK + (size_t)NS * 2048 * DA, O_SCONV = O_SWV + (size_t)NS * 2048 * DA, O_SC = O_SCONV + (size_t)NS * 3 * DB, O_SN = O_SC + (size_t)NS * HB * EB * EB;
constexpr size_t O_SM = O_SN + (size_t)NS * HB * EB, O_END = O_SM + (size_t)NS * HB;

constexpr int RING_BYTES = 155648;
constexpr int LDSCTL_OFF = RING_BYTES, MISC_OFF = LDSCTL_OFF + 320;
constexpr int LDS_BYTES = RING_BYTES + 512;
static_assert(pg8::STAGE_BYTES <= RING_BYTES, "GEMM stage buffers fit");

#define GAS __attribute__((address_space(1)))
#define LAS __attribute__((address_space(3)))
typedef unsigned short bf16;
typedef unsigned v4u __attribute__((ext_vector_type(4)));
typedef unsigned v2u __attribute__((ext_vector_type(2)));
typedef float f32x4 __attribute__((ext_vector_type(4)));
typedef float f32x16 __attribute__((ext_vector_type(16)));
typedef short bf16x8 __attribute__((ext_vector_type(8)));
typedef short s16x4 __attribute__((ext_vector_type(4)));
typedef short v4i16_t __attribute__((ext_vector_type(4)));
typedef GAS unsigned gu32;
#define RLX_AGENT __ATOMIC_RELAXED, __HIP_MEMORY_SCOPE_AGENT
#define LDS_WAIT() asm volatile("s_waitcnt lgkmcnt(0)" ::: "memory")
#define VM_WAIT() asm volatile("s_waitcnt vmcnt(0)" ::: "memory")
#define CFENCE() asm volatile("" ::: "memory")
__device__ __forceinline__ unsigned pk2(float lo, float hi) { return pg8::cvt_pk_bf16(lo, hi); }
__device__ __forceinline__ float bf2f(unsigned short x) { return __uint_as_float((unsigned)x << 16); }
__device__ __forceinline__ float bflo(unsigned w) { return __uint_as_float(w << 16); }
__device__ __forceinline__ float bfhi(unsigned w) { return __uint_as_float(w & 0xffff0000u); }
__device__ __forceinline__ s16x4 tr_read(const LAS bf16* p) { return __builtin_bit_cast(s16x4, __builtin_amdgcn_ds_read_tr16_b64_v4i16((LAS v4i16_t*)p)); }
__device__ __forceinline__ bf16x8 cat8(s16x4 a, s16x4 b) { return (bf16x8){a[0], a[1], a[2], a[3], b[0], b[1], b[2], b[3]}; }
#define MFMA16(a, b, c) __builtin_amdgcn_mfma_f32_16x16x32_bf16((a), (b), (c), 0, 0, 0)
#define MFMA32(a, b, c) __builtin_amdgcn_mfma_f32_32x32x16_bf16((a), (b), (c), 0, 0, 0)
__device__ __forceinline__ int crow(int r, int hi) { return (r & 3) + 8 * (r >> 2) + 4 * hi; }
__device__ __forceinline__ float wave_sum(float v) {
#pragma unroll
    for (int o = 1; o < 64; o <<= 1) v += __shfl_xor(v, o);
    return v;
}
__device__ __forceinline__ float wave_max(float v) {
#pragma unroll
    for (int o = 1; o < 64; o <<= 1) v = fmaxf(v, __shfl_xor(v, o));
    return v;
}
__device__ __forceinline__ float log_sigmoid(float x) { return -(fmaxf(-x, 0.f) + log1pf(expf(-fabsf(x)))); }
__device__ __forceinline__ float sigmoidf(float x) { return 1.0f / (1.0f + expf(-x)); }
__device__ __forceinline__ float siluf(float x) { return x / (1.0f + expf(-x)); }

#define XB_TMO      128
#define XB_XCNT(j)  (256  + 64 * (j))
#define XB_XSUB(j)  (1280 + 64 * (j))
#define XB_XGEN(j)  (2304 + 64 * (j))
#define XB_TOP      3328
#define XB_TOPGEN   3392
#define XCD_BAR_WORDS 3456
#define XB_SPIN_CAP (1u << 18)

__device__ __forceinline__ unsigned xb_ld(unsigned* p)              { return __hip_atomic_load(p, __ATOMIC_RELAXED, __HIP_MEMORY_SCOPE_AGENT); }
__device__ __forceinline__ unsigned xb_add(unsigned* p, unsigned v) { return __hip_atomic_fetch_add(p, v, __ATOMIC_RELAXED, __HIP_MEMORY_SCOPE_AGENT); }
__device__ __forceinline__ unsigned xb_xcc_id() { return (unsigned)__builtin_amdgcn_s_getreg((3 << 11) | 20) & 0xFu; }
#define XB_SPIN(cond, bar) do { unsigned _sp = 0; while (cond) { __builtin_amdgcn_s_sleep(1); \
    if ((++_sp & 255u) == 0u) { if (xb_ld(&(bar)[XB_TMO])) break; if (_sp > XB_SPIN_CAP) { atomicAdd(&(bar)[XB_TMO], 1u); break; } } } } while (0)

struct XcdBarrier {
    unsigned* bar; unsigned x;
    volatile LAS unsigned* st;
};

__device__ __forceinline__ XcdBarrier xcd_barrier_post(unsigned* bar, volatile LAS unsigned* st) {
    XcdBarrier b; b.bar = bar; b.x = xb_xcc_id(); b.st = st;
    if (threadIdx.x == 0) (void)xb_add(&bar[XB_XCNT(b.x)], 1u);
    return b;
}
__device__ __forceinline__ void xcd_barrier_complete(unsigned* bar, unsigned x, unsigned& nloc, unsigned& nx) {
    const unsigned G = gridDim.x * gridDim.y * gridDim.z;
    unsigned sum, cnt, mine, sp = 0u;
    for (;;) {
        sum = 0u; cnt = 0u; mine = 0u;
#pragma unroll
        for (unsigned j = 0; j < 16; ++j) { const unsigned c = xb_ld(&bar[XB_XCNT(j)]); sum += c; cnt += (c > 0u) ? 1u : 0u; mine = (j == x) ? c : mine; }
        if (sum == G) break;
        __builtin_amdgcn_s_sleep(1);
        if ((++sp & 255u) == 0u) { if (xb_ld(&bar[XB_TMO])) break; if (sp > XB_SPIN_CAP) { atomicAdd(&bar[XB_TMO], 1u); break; } }
    }
    nloc = mine > 0u ? mine : 1u; nx = cnt > 0u ? cnt : 1u;
}

__device__ __forceinline__ void xcd_barrier(const XcdBarrier& b) {
    asm volatile("s_waitcnt vmcnt(0)" ::: "memory");
    __syncthreads();
    if (threadIdx.x == 0) {
        unsigned* bar = b.bar;
        __builtin_amdgcn_s_waitcnt(0);
        unsigned nloc = b.st[0], nx = b.st[1];
        if (nloc == 0u) { xcd_barrier_complete(bar, b.x, nloc, nx); b.st[0] = nloc; b.st[1] = nx; }
        const unsigned old = xb_add(&bar[XB_XSUB(b.x)], 1u);
        const unsigned gen = old / nloc;
        if (old + 1u == (gen + 1u) * nloc) {
            __builtin_amdgcn_fence(__ATOMIC_RELEASE, "agent");
            asm volatile("s_waitcnt vmcnt(0)" ::: "memory");
            const unsigned og = xb_add(&bar[XB_TOP], 1u);
            const unsigned tg = og / nx;
            if (og + 1u == (tg + 1u) * nx) xb_add(&bar[XB_TOPGEN], 1u);
            else XB_SPIN(xb_ld(&bar[XB_TOPGEN]) == tg, bar);
            __builtin_amdgcn_fence(__ATOMIC_ACQUIRE, "agent");
            xb_add(&bar[XB_XGEN(b.x)], 1u);
            asm volatile("s_waitcnt vmcnt(0)" ::: "memory");
        } else {
            XB_SPIN(xb_ld(&bar[XB_XGEN(b.x)]) == gen, bar);
            __builtin_amdgcn_fence(__ATOMIC_ACQUIRE, "agent");
            asm volatile("s_waitcnt vmcnt(0)" ::: "memory");
        }
    }
    __syncthreads();
}


struct Frame {
    LAS unsigned char* lds;
    volatile LAS unsigned* MISC;
    gu32* ctl;
    int tid, lane, wave;
    int vcu, G;
    const float* in[24]; float* out; unsigned char* ws;
    bf16 *WIN, *WOUT, *W1, *W2, *WQ, *WK, *XN, *Z, *AO, *CS, *CAT, *X1B, *HFF, *QB, *KB, *CAB;
    float *Gt, *SS1, *SS2, *ML, *BT, *MS, *LSE, *DC, *X1, *SLAB;
};
enum { I_XP = 0, I_XS, I_CK, I_CV, I_SCONV, I_SC, I_SN, I_SM, I_RELB, I_N1G, I_WIN, I_GB, I_CW, I_CB, I_WQ, I_WK, I_AOG, I_MHG, I_SKIP, I_WOUT, I_N2G, I_W1, I_W2, I_FG };


__device__ __forceinline__ void copy_burst(Frame& F, unsigned q) {
    const unsigned s = q / CP_PER_SLICE, k = q - s * CP_PER_SLICE, tsel = s >> 7, b = s & 127u;
    const f32x4* src = (const f32x4*)((tsel ? F.in[I_CV] : F.in[I_CK]) + (size_t)b * 2048 * DA + DA);
    f32x4* dst = (f32x4*)(F.out + (tsel ? O_SWV : O_SWK) + (size_t)b * 2048 * DA);
    const unsigned i0 = k * CP_BURST4 + (unsigned)F.tid;
    f32x4 v[16];
#pragma unroll
    for (int j = 0; j < 16; ++j) { const unsigned i = i0 + 512u * j; if (i < CP_N4) v[j] = __builtin_nontemporal_load(src + i); }
#pragma unroll
    for (int j = 0; j < 16; ++j) { const unsigned i = i0 + 512u * j; if (i < CP_N4) __builtin_nontemporal_store(v[j], dst + i); }
}
__device__ __forceinline__ void xcd_barrier_steal(const XcdBarrier& b, Frame& F) {
    asm volatile("s_waitcnt vmcnt(0)" ::: "memory");
    __syncthreads();
    volatile LAS unsigned* sw = F.MISC + 12;
    unsigned gen = 0u; bool leader = true;
    if (threadIdx.x == 0) {
        unsigned* bar = b.bar;
        __builtin_amdgcn_s_waitcnt(0);
        unsigned nloc = b.st[0], nx = b.st[1];
        if (nloc == 0u) { xcd_barrier_complete(bar, b.x, nloc, nx); b.st[0] = nloc; b.st[1] = nx; }
        const unsigned old = xb_add(&bar[XB_XSUB(b.x)], 1u);
        gen = old / nloc;
        if (old + 1u == (gen + 1u) * nloc) {
            __builtin_amdgcn_fence(__ATOMIC_RELEASE, "agent");
            asm volatile("s_waitcnt vmcnt(0)" ::: "memory");
            const unsigned og = xb_add(&bar[XB_TOP], 1u);
            const unsigned tg = og / nx;
            if (og + 1u == (tg + 1u) * nx) xb_add(&bar[XB_TOPGEN], 1u);
            else XB_SPIN(xb_ld(&bar[XB_TOPGEN]) == tg, bar);
            __builtin_amdgcn_fence(__ATOMIC_ACQUIRE, "agent");
            xb_add(&bar[XB_XGEN(b.x)], 1u);
            asm volatile("s_waitcnt vmcnt(0)" ::: "memory");
            sw[0] = 0u;
        } else { leader = false; sw[0] = 1u; }
    }
    unsigned iters = 0u;
    for (;;) {
        __syncthreads();
        if (threadIdx.x == 0 && !leader) {
            if (xb_ld(&b.bar[XB_XGEN(b.x)]) != gen || xb_ld(&b.bar[XB_TMO]) != 0u) sw[0] = 0u;
            else { unsigned q = CP_NQ; if (sw[2] == 0u) { q = __hip_atomic_fetch_add((unsigned*)(F.ctl + CW_COPYQ), 1u, __ATOMIC_RELAXED, __HIP_MEMORY_SCOPE_AGENT); if (q >= CP_NQ) sw[2] = 1u; } sw[1] = q;
                   if (++iters > (1u << 22)) { atomicAdd(&b.bar[XB_TMO], 1u); sw[0] = 0u; } }
        }
        __syncthreads();
        if (sw[0] == 0u) break;
        const unsigned q = sw[1];
        if (q < CP_NQ) copy_burst(F, q); else __builtin_amdgcn_s_sleep(8);
    }
    if (threadIdx.x == 0 && !leader) { __builtin_amdgcn_fence(__ATOMIC_ACQUIRE, "agent"); asm volatile("s_waitcnt vmcnt(0)" ::: "memory"); }
    __syncthreads();
}
__device__ __forceinline__ void copy_drain(Frame& F) {
    volatile LAS unsigned* sw = F.MISC + 12;
    for (;;) {
        __syncthreads();
        if (threadIdx.x == 0) { unsigned q = CP_NQ; if (sw[2] == 0u) { q = __hip_atomic_fetch_add((unsigned*)(F.ctl + CW_COPYQ), 2u, __ATOMIC_RELAXED, __HIP_MEMORY_SCOPE_AGENT); if (q >= CP_NQ) sw[2] = 1u; } sw[1] = q; }
        __syncthreads();
        const unsigned q = sw[1];
        if (q >= CP_NQ) break;
        copy_burst(F, q); if (q + 1u < CP_NQ) copy_burst(F, q + 1u);
    }
}

template <int NT, class Epi>
__device__ __forceinline__ void small_gemm(Frame& F, const bf16* A, const bf16* Bt, int K, int kbeg, int kend, int n0, const Epi& E) {
    const int fr = F.lane & 15, fq = F.lane >> 4, r = 16 * F.wave + fr;
    const bf16* ap = A + (size_t)r * K + 8 * fq;
    const bf16* bp = Bt + (size_t)(n0 + fr) * K + 8 * fq;
    f32x4 acc[NT];
#pragma unroll
    for (int nt = 0; nt < NT; ++nt) acc[nt] = (f32x4){0.f, 0.f, 0.f, 0.f};
    bf16x8 a0[4], b0[NT][4], a1[4], b1[NT][4];
#define SG_LOAD(a_, b_, k_) do { _Pragma("unroll") for (int j = 0; j < 4; ++j) { a_[j] = *(const bf16x8*)(ap + (k_) + 32 * j); \
        _Pragma("unroll") for (int nt = 0; nt < NT; ++nt) b_[nt][j] = *(const bf16x8*)(bp + (size_t)nt * 16 * K + (k_) + 32 * j); } } while (0)
#define SG_MMA(a_, b_) do { _Pragma("unroll") for (int j = 0; j < 4; ++j) _Pragma("unroll") for (int nt = 0; nt < NT; ++nt) acc[nt] = MFMA16(b_[nt][j], a_[j], acc[nt]); } while (0)
    SG_LOAD(a0, b0, kbeg);
    for (int k = kbeg; k < kend; k += 256) {
        SG_LOAD(a1, b1, k + 128);
        SG_MMA(a0, b0);
        if (k + 256 < kend) SG_LOAD(a0, b0, k + 256);
        SG_MMA(a1, b1);
    }
#undef SG_LOAD
#undef SG_MMA
    E(acc, r, n0, fq);
}
struct SEpiZ { bf16* Z; float* G;
    __device__ __forceinline__ void operator()(const f32x4 (&acc)[2], int r, int n0, int fq) const {
#pragma unroll
        for (int nt = 0; nt < 2; ++nt) { const int col = n0 + 16 * nt + 4 * fq; v2u w; w.x = pk2(acc[nt][0], acc[nt][1]); w.y = pk2(acc[nt][2], acc[nt][3]);
            *(v2u*)(Z + (size_t)(MP + r) * ZP + col) = w;
            if (col >= ZG && col < ZG + 8) *(f32x4*)(G + (size_t)(MP + r) * 8 + (col - ZG)) = acc[nt]; } } };
struct SEpiX1 { const float* xs; float* X1; bf16* X1B; float* SS;
    __device__ __forceinline__ void operator()(const f32x4 (&acc)[4], int r, int n0, int fq) const {
        float ss = 0.f;
#pragma unroll
        for (int nt = 0; nt < 4; ++nt) { const int col = n0 + 16 * nt + 4 * fq; const f32x4 v = acc[nt] + *(const f32x4*)(xs + (size_t)r * DM + col);
            *(f32x4*)(X1 + (size_t)(MP + r) * DM + col) = v; v2u w; w.x = pk2(v[0], v[1]); w.y = pk2(v[2], v[3]); *(v2u*)(X1B + (size_t)(MP + r) * DM + col) = w;
            ss += (v[0] * v[0] + v[1] * v[1]) + (v[2] * v[2] + v[3] * v[3]); }
        ss += __shfl_xor(ss, 16); ss += __shfl_xor(ss, 32);
        if (fq == 0) SS[(size_t)(MP + r) * 16 + (n0 >> 6)] = ss; } };
struct SEpiFF1 { bf16* H; const float* SS;
    __device__ __forceinline__ void operator()(const f32x4 (&acc)[2], int r, int n0, int fq) const {
        const f32x4* sp = (const f32x4*)(SS + (size_t)(MP + r) * 16); const f32x4 s0 = sp[0], s1 = sp[1], s2 = sp[2], s3 = sp[3];
        const float tot = ((s0[0] + s0[1]) + (s0[2] + s0[3])) + ((s1[0] + s1[1]) + (s1[2] + s1[3])) + ((s2[0] + s2[1]) + (s2[2] + s2[3])) + ((s3[0] + s3[1]) + (s3[2] + s3[3]));
        const float rstd = 1.0f / sqrtf(tot * (1.0f / 1024.0f) + EPS);
#pragma unroll
        for (int nt = 0; nt < 2; ++nt) { const int col = n0 + 16 * nt + 4 * fq; float o[4];
#pragma unroll
            for (int e = 0; e < 4; ++e) { const float a = fmaxf(acc[nt][e] * rstd, 0.f); o[e] = a * a; }
            v2u w; w.x = pk2(o[0], o[1]); w.y = pk2(o[2], o[3]); *(v2u*)(H + (size_t)(MP + r) * DFF + col) = w; } } };
struct SEpiSlab { float* slab;
    __device__ __forceinline__ void operator()(const f32x4 (&acc)[2], int r, int n0, int fq) const {
#pragma unroll
        for (int nt = 0; nt < 2; ++nt) { const int col = n0 + 16 * nt + 4 * fq; *(f32x4*)(slab + (size_t)r * DM + col) = acc[nt]; } } };

__device__ __forceinline__ void p0_transpose_item(const float* W, int K, int N, int Npad, const float* gain, bf16* WT, LAS float* scr, int item, int lane) {
    const int nblk = Npad / 32, kb = item / nblk, nb = item % nblk, k0 = 64 * kb, n0 = 32 * nb;
    const int nn = n0 + (lane & 31);
#pragma unroll
    for (int i = 0; i < 32; ++i) { const int kk = 2 * i + (lane >> 5); float w = nn < N ? W[(size_t)(k0 + kk) * N + nn] : 0.f; if (gain) w *= gain[k0 + kk]; scr[kk * 33 + (lane & 31)] = w; }
    LDS_WAIT(); CFENCE();
    const int c = lane & 7;
#pragma unroll
    for (int j = 0; j < 4; ++j) { const int n = (lane >> 3) + 8 * j; const LAS float* s = scr + (8 * c) * 33 + n;
        v4u o; o.x = pk2(s[0 * 33], s[1 * 33]); o.y = pk2(s[2 * 33], s[3 * 33]); o.z = pk2(s[4 * 33], s[5 * 33]); o.w = pk2(s[6 * 33], s[7 * 33]);
        *(GAS v4u*)(WT + (size_t)(n0 + n) * K + k0 + 8 * c) = o; }
    LDS_WAIT(); CFENCE();
}
__device__ __forceinline__ void p0_prologue(Frame& F) {
    LAS float* scr = (LAS float*)(F.lds + F.wave * 16384);
    const int gw = F.vcu * NWAVES + F.wave, NGW = F.G * NWAVES;
    const int gt = F.vcu * 512 + F.tid, NT = F.G * 512;
    REP(1) {
    constexpr int I_IN = 16 * 80, I_OUT = 16 * 32, I_1 = 16 * 128, I_2 = 64 * 32, NITEMS = I_IN + I_OUT + I_1 + I_2;
    for (int it = gw; it < NITEMS; it += NGW) {
        int r = it;
        if (r < I_IN) { p0_transpose_item(F.in[I_WIN], DM, DIN, ZP, F.in[I_N1G], F.WIN, scr, r, F.lane); continue; } r -= I_IN;
        if (r < I_OUT) { p0_transpose_item(F.in[I_WOUT], DM, DM, DM, nullptr, F.WOUT, scr, r, F.lane); continue; } r -= I_OUT;
        if (r < I_1) { p0_transpose_item(F.in[I_W1], DM, DFF, DFF, F.in[I_N2G], F.W1, scr, r, F.lane); continue; } r -= I_1;
        p0_transpose_item(F.in[I_W2], DFF, DM, DM, nullptr, F.W2, scr, r, F.lane);
    }
    for (int idx = gt; idx < 2 * 102400; idx += NT) { const int mat = idx / 102400, r = idx % 102400, h = r / 25600, e = (r % 25600) / 160, d = r % 160;
        const float s = (mat ? F.in[I_WK] : F.in[I_WQ])[h * 25600 + d * 160 + e] * (mat ? 0.07905694150420949f : 1.0f);
        (mat ? F.WK : F.WQ)[h * 25600 + e * 160 + d] = (bf16)(pk2(s, 0.f) & 0xffffu); }
    for (int m0 = gw; m0 < MT; m0 += 2 * NGW) {
        const int m1 = m0 + NGW; const bool has1 = m1 < MT; const int m1c = has1 ? m1 : m0;
        const float* x0 = m0 < MP ? F.in[I_XP] + (size_t)m0 * DM : F.in[I_XS] + (size_t)(m0 - MP) * DM;
        const float* x1 = m1c < MP ? F.in[I_XP] + (size_t)m1c * DM : F.in[I_XS] + (size_t)(m1c - MP) * DM;
        const GAS f32x4* xr0 = (const GAS f32x4*)x0 + F.lane; const GAS f32x4* xr1 = (const GAS f32x4*)x1 + F.lane;
        f32x4 v[4], u[4]; float s0 = 0.f, s1 = 0.f;
#pragma unroll
        for (int j = 0; j < 4; ++j) { v[j] = xr0[64 * j]; u[j] = xr1[64 * j]; }
#pragma unroll
        for (int j = 0; j < 4; ++j) { s0 += (v[j].x * v[j].x + v[j].y * v[j].y) + (v[j].z * v[j].z + v[j].w * v[j].w); s1 += (u[j].x * u[j].x + u[j].y * u[j].y) + (u[j].z * u[j].z + u[j].w * u[j].w); }
        const float r0 = 1.0f / sqrtf(wave_sum(s0) * (1.f / DM) + EPS), r1 = 1.0f / sqrtf(wave_sum(s1) * (1.f / DM) + EPS);
        GAS unsigned long long* o0 = (GAS unsigned long long*)(F.XN + (size_t)m0 * DM) + F.lane; GAS unsigned long long* o1 = (GAS unsigned long long*)(F.XN + (size_t)m1c * DM) + F.lane;
#pragma unroll
        for (int j = 0; j < 4; ++j) o0[64 * j] = (unsigned long long)pk2(v[j].x * r0, v[j].y * r0) | ((unsigned long long)pk2(v[j].z * r0, v[j].w * r0) << 32);
        if (has1) {
#pragma unroll
            for (int j = 0; j < 4; ++j) o1[64 * j] = (unsigned long long)pk2(u[j].x * r1, u[j].y * r1) | ((unsigned long long)pk2(u[j].z * r1, u[j].w * r1) << 32); }
    }
    for (int idx = gt; idx < NS * 2 * DB; idx += NT) { const int b = idx / (2 * DB), rr = (idx % (2 * DB)) / DB, ch = idx % DB;
        F.out[O_SCONV + (size_t)b * 3 * DB + rr * DB + ch] = F.in[I_SCONV][(size_t)b * 3 * DB + (rr + 1) * DB + ch]; }
    }
}

__device__ __forceinline__ int t5_bucket(int dist) {
    if (dist < 16) return dist;
    const int large = 16 + (int)(logf((float)dist / 16.0f) / 4.852030263919617f * 16.0f);
    return large < 31 ? large : 31;
}
__device__ __forceinline__ void build_bias_table(Frame& F, LAS float* bt) {
    for (int idx = F.tid; idx < 18 * 132; idx += 512) { const int gh = idx / 132, j = idx % 132, g = gh / 6, h = gh % 6;
        bt[idx] = j <= 128 ? F.in[I_RELB][t5_bucket(j << (2 * g)) * 6 + h] : 0.f; }
}
constexpr int VPITCH = 72;
constexpr int P2_BIAS_OFF = 0, P2_KL_OFF = 18 * 132 * 4, P2_VL_OFF = P2_KL_OFF + 384 * VPITCH * 2, P2_SA_OFF = P2_KL_OFF;
static_assert(P2_VL_OFF + 384 * VPITCH * 2 <= RING_BYTES, "attention LDS");
__device__ __forceinline__ void attn_prompt_wgitem(Frame& F, int wi, const LAS float* biasT) {
    int lane = F.lane; asm volatile("" : "+v"(lane));
    const int r32 = lane & 31, hi = lane >> 5, tid = lane + 64 * F.wave;
    const int g = wi / 384, rem = wi - g * 384, bh = rem >> 5, grp = rem & 31, b = bh / 6, h = bh - b * 6;
    const int sh = 2 * g, nper = 256 >> sh, tile0 = grp * 8, r = tile0 / nper, n0 = tile0 & (nper - 1), n = n0 + F.wave;
    const bf16* Zb = F.Z + (size_t)b * SEQ * ZP;
    LAS bf16* KL = (LAS bf16*)(F.lds + P2_KL_OFF); LAS bf16* VL = (LAS bf16*)(F.lds + P2_VL_OFF);
    const int tq = ((32 * n + r32) << sh) + r;
    bf16x8 qf[4];
    { const bf16* qrow = Zb + (size_t)tq * ZP + ZQ + h * 64 + 8 * hi;
#pragma unroll
      for (int kk = 0; kk < 4; ++kk) qf[kk] = *(const bf16x8*)(qrow + 16 * kk); }
    __syncthreads();
    {
        v4u pc[12];
#pragma unroll
        for (int j = 0; j < 12; ++j) { const int p = tid + 512 * j, arr = p >= 3072, pp = p - arr * 3072, row = pp >> 3, c8 = pp & 7, uk = 32 * n0 - 128 + row;
            pc[j] = uk >= 0 ? *(const v4u*)(Zb + (size_t)((uk << sh) + r) * ZP + (arr ? ZV : ZK) + h * 64 + c8 * 8) : (v4u){0u, 0u, 0u, 0u}; }
#pragma unroll
        for (int j = 0; j < 12; ++j) { const int p = tid + 512 * j, arr = p >= 3072, pp = p - arr * 3072, row = pp >> 3, c8 = pp & 7;
            *(LAS v4u*)((arr ? VL : KL) + row * VPITCH + c8 * 8) = pc[j]; }
    }
    __syncthreads();
    f32x16 o0, o1;
#pragma unroll
    for (int i = 0; i < 16; ++i) { o0[i] = 0.f; o1[i] = 0.f; }
    float mrun = -1e30f, lrun = 0.f;
    const LAS float* bt = biasT + (g * 6 + h) * 132;
    for (int kt = n < 4 ? 4 - n : 0; kt < 5; ++kt) {
        const int tj = F.wave + kt;
        const LAS bf16* kp = KL + (32 * tj + r32) * VPITCH + 8 * hi;
        f32x16 st;
#pragma unroll
        for (int i = 0; i < 16; ++i) st[i] = 0.f;
#pragma unroll
        for (int kk = 0; kk < 4; ++kk) st = MFMA32(*(const LAS bf16x8*)(kp + 16 * kk), qf[kk], st);
        const int jb = r32 + 128 - 32 * kt;
        float mt = -1e30f;
#pragma unroll
        for (int i = 0; i < 16; ++i) { const int j = jb - crow(i, hi); const bool ok = (j >= 0) && (j <= 128); const int jc = j < 0 ? 0 : (j > 128 ? 128 : j);
            const float sc = ok ? st[i] * 0.125f + bt[jc] : -1e30f; st[i] = sc; mt = fmaxf(mt, sc); }
        mt = fmaxf(mt, __shfl_xor(mt, 32));
        const float mnew = fmaxf(mrun, mt), alpha = __expf(mrun - mnew);
        float ps = 0.f;
#pragma unroll
        for (int i = 0; i < 16; ++i) { const float p = __expf(st[i] - mnew); st[i] = p; ps += p; }
        ps += __shfl_xor(ps, 32);
        lrun = lrun * alpha + ps; mrun = mnew;
#pragma unroll
        for (int i = 0; i < 16; ++i) { o0[i] *= alpha; o1[i] *= alpha; }
        v4u p0, p1;
        p0.x = pk2(st[0], st[1]); p0.y = pk2(st[2], st[3]); p0.z = pk2(st[4], st[5]); p0.w = pk2(st[6], st[7]);
        p1.x = pk2(st[8], st[9]); p1.y = pk2(st[10], st[11]); p1.z = pk2(st[12], st[13]); p1.w = pk2(st[14], st[15]);
        const bf16x8 pb0 = __builtin_bit_cast(bf16x8, p0), pb1 = __builtin_bit_cast(bf16x8, p1);
        const LAS bf16* trb = VL + (32 * tj + 4 * hi + ((lane & 15) >> 2)) * VPITCH + 16 * ((lane >> 4) & 1) + 4 * (lane & 3);
        const bf16x8 a00 = cat8(tr_read(trb), tr_read(trb + 8 * VPITCH));
        const bf16x8 a01 = cat8(tr_read(trb + 16 * VPITCH), tr_read(trb + 24 * VPITCH));
        const bf16x8 a10 = cat8(tr_read(trb + 32), tr_read(trb + 8 * VPITCH + 32));
        const bf16x8 a11 = cat8(tr_read(trb + 16 * VPITCH + 32), tr_read(trb + 24 * VPITCH + 32));
        o0 = MFMA32(a00, pb0, o0); o0 = MFMA32(a01, pb1, o0);
        o1 = MFMA32(a10, pb0, o1); o1 = MFMA32(a11, pb1, o1);
    }
    const float inv = 1.0f / lrun, lse = mrun + logf(lrun);
    const size_t orow = (size_t)g * MP + (size_t)b * SEQ + tq;
    bf16* op = F.AO + orow * DA + h * 64 + 4 * hi;
#pragma unroll
    for (int k = 0; k < 4; ++k) { v2u w; w.x = pk2(o0[4 * k] * inv, o0[4 * k + 1] * inv); w.y = pk2(o0[4 * k + 2] * inv, o0[4 * k + 3] * inv); *(v2u*)(op + 8 * k) = w;
                                  v2u w2; w2.x = pk2(o1[4 * k] * inv, o1[4 * k + 1] * inv); w2.y = pk2(o1[4 * k + 2] * inv, o1[4 * k + 3] * inv); *(v2u*)(op + 32 + 8 * k) = w2; }
    if (hi == 0) F.LSE[orow * 6 + h] = lse;
}

__device__ __forceinline__ void attn_sample_item(Frame& F, int b, const LAS float* biasT, LAS float* obuf  ) {
    const int lane = F.lane, sub = lane >> 4, d4 = lane & 15, h = F.wave;
    const bf16* zrow = F.Z + (size_t)(MP + b) * ZP;
    __syncthreads();
    if (h < 6) {
        f32x4 q; { const v2u w = *(const v2u*)(zrow + ZQ + h * 64 + 4 * d4); q = (f32x4){bflo(w.x), bfhi(w.x), bflo(w.y), bfhi(w.y)}; }
        f32x4 kn, vn; { const v2u w = *(const v2u*)(zrow + ZK + h * 64 + 4 * d4); kn = (f32x4){bflo(w.x), bfhi(w.x), bflo(w.y), bfhi(w.y)};
                        const v2u w2 = *(const v2u*)(zrow + ZV + h * 64 + 4 * d4); vn = (f32x4){bflo(w2.x), bfhi(w2.x), bflo(w2.y), bfhi(w2.y)}; }
        if (sub == 0) { *(f32x4*)(F.out + O_SWK + ((size_t)b * 2048 + 2047) * DA + h * 64 + 4 * d4) = kn; *(f32x4*)(F.out + O_SWV + ((size_t)b * 2048 + 2047) * DA + h * 64 + 4 * d4) = vn; }
        const float* ck = F.in[I_CK] + (size_t)b * 2048 * DA + h * 64 + 4 * d4; const float* cv = F.in[I_CV] + (size_t)b * 2048 * DA + h * 64 + 4 * d4;
        float m = -1e30f, l = 0.f; f32x4 o = {0.f, 0.f, 0.f, 0.f};
        for (int it0 = 0; it0 < 97; it0 += 16) {
            f32x4 kb[16], vb[16];
#pragma unroll
            for (int u = 0; u < 16; ++u) { const int idx = 4 * (it0 + u) + sub; const int ic = idx < 387 ? idx : 386; const int g = ic / 129, j = ic - g * 129;
                const int row = j ? 2048 - (j << (2 * g)) : 2047; kb[u] = *(const f32x4*)(ck + (size_t)row * DA); vb[u] = *(const f32x4*)(cv + (size_t)row * DA); }
#pragma unroll
            for (int u = 0; u < 16; ++u) { const int idx = 4 * (it0 + u) + sub; const bool ok = idx < 387; const int ic = ok ? idx : 386; const int g = ic / 129, j = ic - g * 129;
                const f32x4 kk = j ? kb[u] : kn, vv = j ? vb[u] : vn;
                float s = (q[0] * kk[0] + q[1] * kk[1]) + (q[2] * kk[2] + q[3] * kk[3]);
                s += __shfl_xor(s, 1); s += __shfl_xor(s, 2); s += __shfl_xor(s, 4); s += __shfl_xor(s, 8);
                s = ok ? s * 0.125f + biasT[(g * 6 + h) * 132 + j] : -1e30f;
                const float mn = fmaxf(m, s), al = __expf(m - mn), p = ok ? __expf(s - mn) : 0.f;
                l = l * al + p; o = o * al + vv * p; m = mn; }
        }
        float M = fmaxf(m, __shfl_xor(m, 16)); M = fmaxf(M, __shfl_xor(M, 32));
        const float sc = __expf(m - M); l *= sc; o = o * sc;
        l += __shfl_xor(l, 16); l += __shfl_xor(l, 32);
#pragma unroll
        for (int e = 0; e < 4; ++e) { o[e] += __shfl_xor(o[e], 16); o[e] += __shfl_xor(o[e], 32); }
        if (sub == 0) { const float inv = 1.0f / l; *(LAS f32x4*)(obuf + h * 64 + 4 * d4) = o * inv; }
    }
    __syncthreads();
    if (F.tid < 384) {
        float ss = 0.f;
#pragma unroll
        for (int k = 0; k < 6; ++k) { const float v = obuf[k * 64 + lane]; ss += v * v; }
        ss = wave_sum(ss);
        const float rstd = 1.0f / sqrtf(ss * (1.0f / 384.0f) + EPS);
        const int c = F.tid;
        F.CAT[(size_t)(MP + b) * DM + c] = (bf16)(pk2(obuf[c] * rstd * F.in[I_AOG][c], 0.f) & 0xffffu);
    }
}

__device__ __forceinline__ void mlstm_sample_item(Frame& F, int item, LAS float* sb  ) {
    const int b = item >> 2, h = item & 3, tid = F.tid, lane = F.lane;
    LAS float* cact = sb; LAS float* vv = sb + 160; LAS float* qv = sb + 320; LAS float* kv = sb + 480; LAS float* hv = sb + 640; LAS float* red = sb + 800;
    const bf16* zrow = F.Z + (size_t)(MP + b) * ZP;
    __syncthreads();
    if (tid < 160) { const int ch = h * 160 + tid; const float x3 = bf2f(zrow[ZX + ch]);
        const float* sc = F.in[I_SCONV] + (size_t)b * 3 * DB + ch; const float* cw = F.in[I_CW] + ch;
        const float c = F.in[I_CB][ch] + cw[0] * sc[0] + cw[DB] * sc[DB] + cw[2 * DB] * sc[2 * DB] + cw[3 * DB] * x3;
        cact[tid] = siluf(c); vv[tid] = x3; F.out[O_SCONV + (size_t)b * 3 * DB + 2 * DB + ch] = x3; }
    __syncthreads();
    if (tid < 320) { const int e = tid % 160, mat = tid / 160; const v4u* W = (const v4u*)((mat ? F.WK : F.WQ) + (size_t)h * 25600 + e * 160);
        v4u wv[20];
#pragma unroll
        for (int c8 = 0; c8 < 20; ++c8) wv[c8] = W[c8];
        float s = 0.f;
#pragma unroll
        for (int c8 = 0; c8 < 20; ++c8) { const LAS float* ca = cact + 8 * c8;
            s += (ca[0] * bflo(wv[c8].x) + ca[1] * bfhi(wv[c8].x)) + (ca[2] * bflo(wv[c8].y) + ca[3] * bfhi(wv[c8].y)) + (ca[4] * bflo(wv[c8].z) + ca[5] * bfhi(wv[c8].z)) + (ca[6] * bflo(wv[c8].w) + ca[7] * bfhi(wv[c8].w)); }
        if (mat) kv[e] = s; else qv[e] = s; }
    __syncthreads();
    const float gi = F.Gt[(size_t)(MP + b) * 8 + h] + F.in[I_GB][h], gf = F.Gt[(size_t)(MP + b) * 8 + 4 + h] + F.in[I_GB][4 + h];
    const float a = log_sigmoid(gf), m0 = F.in[I_SM][b * 4 + h];
    const float mt = fmaxf(a + m0, gi), wst = expf(a + m0 - mt), wkk = expf(gi - mt);
    const float* nst = F.in[I_SN] + (size_t)(b * 4 + h) * 160;
    float qk = 0.f, nq = 0.f;
    for (int e = lane; e < 160; e += 64) { qk += qv[e] * kv[e]; nq += nst[e] * qv[e]; }
    qk = wave_sum(qk); nq = wave_sum(nq);
    const float A = qk * wkk, den = wst * nq + A, denom = fmaxf(fabsf(den), expf(-mt));
    const float* Cst = F.in[I_SC] + (size_t)(b * 4 + h) * 25600; float* Cout = F.out + O_SC + (size_t)(b * 4 + h) * 25600;
    {
        const int gl = lane >> 3, jl = lane & 7;
        f32x4 c4[3][5];
#pragma unroll
        for (int p = 0; p < 3; ++p) { const int rl = p * 8 + gl; const bool ok = rl < 20; const int v = F.wave * 20 + (ok ? rl : 0);
#pragma unroll
            for (int i = 0; i < 5; ++i) c4[p][i] = __builtin_nontemporal_load((const f32x4*)(Cst + v * 160) + jl + 8 * i); }
#pragma unroll
        for (int p = 0; p < 3; ++p) { const int rl = p * 8 + gl; const bool ok = rl < 20; const int v = F.wave * 20 + (ok ? rl : 0);
            const float wv = wkk * vv[v]; float dot = 0.f;
#pragma unroll
            for (int i = 0; i < 5; ++i) { const f32x4 q4 = *(const LAS f32x4*)(qv + 4 * (jl + 8 * i)), k4 = *(const LAS f32x4*)(kv + 4 * (jl + 8 * i));
                dot += (c4[p][i][0] * q4[0] + c4[p][i][1] * q4[1]) + (c4[p][i][2] * q4[2] + c4[p][i][3] * q4[3]);
                const f32x4 cn = c4[p][i] * wst + k4 * wv;
                if (ok) __builtin_nontemporal_store(cn, (f32x4*)(Cout + v * 160) + jl + 8 * i); }
            dot += __shfl_xor(dot, 1); dot += __shfl_xor(dot, 2); dot += __shfl_xor(dot, 4);
            if (ok && jl == 0) hv[v] = (wst * dot + A * vv[v]) / denom; }
    }
    __syncthreads();
    if (tid < 160) F.out[O_SN + (size_t)(b * 4 + h) * 160 + tid] = wst * nst[tid] + wkk * kv[tid];
    if (tid == 0) F.out[O_SM + b * 4 + h] = mt;
    float ss = 0.f;
    for (int e = lane; e < 160; e += 64) ss += hv[e] * hv[e];
    ss = wave_sum(ss);
    const float rs = 1.0f / sqrtf(ss * (1.0f / 160.0f) + EPS);
    if (tid < 160) { const int ch = h * 160 + tid; const float hb = hv[tid] * rs * F.in[I_MHG][ch]; const float ob = bf2f(zrow[ZO + ch]);
        const float o = sigmoidf(ob) * (hb + F.in[I_SKIP][ch] * cact[tid]);
        F.CAT[(size_t)(MP + b) * DM + DA + ch] = (bf16)(pk2(o, 0.f) & 0xffffu); }
}

constexpr int CAP = 168, VTP = 176;
constexpr int ML_CA = 0, ML_KS = 128 * CAP * 2, ML_VT = 2 * 128 * CAP * 2, ML_GA = ML_VT + 128 * VTP * 2;
constexpr int MC_VT = 0, MC_GA = 128 * VTP * 2;
static_assert(ML_GA + 4096 <= RING_BYTES, "mlstm LDS");
__device__ __forceinline__ void mlstm_vt_ones(Frame& F, LAS bf16* VT) {
    for (int idx = F.tid; idx < 256; idx += 512) { const int t = idx >> 1, part = idx & 1;
        *(LAS v4u*)(VT + t * VTP + 160 + part * 8) = part ? (v4u){0u, 0u, 0u, 0u} : (v4u){0x3F80u, 0u, 0u, 0u}; }
}
__device__ __forceinline__ void mlstm_stageA_item(Frame& F, int item) {
    int lane = F.lane; asm volatile("" : "+v"(lane));
    const int bh = item >> 6, c = item & 63, b = bh >> 2, h = bh & 3, fr = lane & 15, fq = lane >> 4, tid = lane + 64 * F.wave;
    const size_t row0 = (size_t)b * SEQ + (size_t)c * 128;
    LAS bf16* CA = (LAS bf16*)(F.lds + ML_CA); LAS bf16* KS = (LAS bf16*)(F.lds + ML_KS); LAS bf16* VT = (LAS bf16*)(F.lds + ML_VT); LAS float* GA = (LAS float*)(F.lds + ML_GA);
    __syncthreads();
    if (F.wave == 0) {
        const float gb_i = F.in[I_GB][h], gb_f = F.in[I_GB][4 + h];
        const float* g0 = F.Gt + (row0 + 2 * lane) * 8;
        const float gi0 = g0[h] + gb_i, gf0 = g0[4 + h] + gb_f, gi1 = g0[8 + h] + gb_i, gf1 = g0[12 + h] + gb_f;
        const float lf0 = log_sigmoid(gf0), lf1 = log_sigmoid(gf1), pair = lf0 + lf1;
        float incl = pair;
#pragma unroll
        for (int o = 1; o < 64; o <<= 1) { const float t = __shfl_up(incl, o); if (lane >= o) incl += t; }
        const float a0 = (incl - pair) + lf0, a1 = incl;
        const float btot = __shfl(incl, 63);
        const float wl0 = btot - a0 + gi0, wl1 = btot - a1 + gi1;
        const float ml = wave_max(fmaxf(wl0, wl1));
        GA[2 * lane] = expf(wl0 - ml); GA[2 * lane + 1] = expf(wl1 - ml);
        if (lane == 0) { F.ML[item] = ml; F.BT[item] = btot; }
    }
    if (tid < 440) {
        const int cg = tid % 20, tg = tid / 20, t0 = 6 * tg, ch0 = h * 160 + cg * 8;
        const bf16* Zb = F.Z + (size_t)b * SEQ * ZP + ZX + ch0;
        v4u xr[9];
#pragma unroll
        for (int k = 0; k < 9; ++k) { const int tl = t0 - 3 + k, tk = c * 128 + tl; xr[k] = (tk >= 0 && tl < 128) ? *(const v4u*)(Zb + (size_t)tk * ZP) : (v4u){0u, 0u, 0u, 0u}; }
        f32x4 wa[4], wb[4];
#pragma unroll
        for (int k = 0; k < 4; ++k) { wa[k] = *(const f32x4*)(F.in[I_CW] + k * DB + ch0); wb[k] = *(const f32x4*)(F.in[I_CW] + k * DB + ch0 + 4); }
        const f32x4 ba = *(const f32x4*)(F.in[I_CB] + ch0), bb = *(const f32x4*)(F.in[I_CB] + ch0 + 4);
#pragma unroll
        for (int i = 0; i < 6; ++i) { const int t = t0 + i; if (t < 128) {
            f32x4 ya = ba, yb = bb;
#pragma unroll
            for (int k = 0; k < 4; ++k) { const v4u x = xr[i + k];
                ya[0] += wa[k][0] * bflo(x.x); ya[1] += wa[k][1] * bfhi(x.x); ya[2] += wa[k][2] * bflo(x.y); ya[3] += wa[k][3] * bfhi(x.y);
                yb[0] += wb[k][0] * bflo(x.z); yb[1] += wb[k][1] * bfhi(x.z); yb[2] += wb[k][2] * bflo(x.w); yb[3] += wb[k][3] * bfhi(x.w); }
            v4u o; o.x = pk2(siluf(ya[0]), siluf(ya[1])); o.y = pk2(siluf(ya[2]), siluf(ya[3])); o.z = pk2(siluf(yb[0]), siluf(yb[1])); o.w = pk2(siluf(yb[2]), siluf(yb[3]));
            *(LAS v4u*)(CA + t * CAP + cg * 8) = o;
            *(v4u*)(F.CAB + (row0 + t) * DB + ch0) = o;
            *(LAS v4u*)(VT + t * VTP + cg * 8) = xr[i + 3]; } }
    }
    mlstm_vt_ones(F, VT);
    __syncthreads();
    {
        const int ntile = F.wave < 4 ? 3 : 2;
        bf16x8 wf[3][5];
#pragma unroll
        for (int j = 0; j < 3; ++j) { const int ti = F.wave + 8 * (j < ntile ? j : 0); const bf16* wb_ = (ti >= 10 ? F.WK : F.WQ) + (size_t)h * 25600 + (size_t)((ti % 10) * 16 + fr) * 160 + 8 * fq;
#pragma unroll
            for (int kk = 0; kk < 5; ++kk) wf[j][kk] = *(const bf16x8*)(wb_ + 32 * kk); }
#pragma unroll
        for (int j = 0; j < 3; ++j) { if (j < ntile) { const int ti = F.wave + 8 * j; const bool isk = ti >= 10; const int e0 = (ti % 10) * 16 + 4 * fq;
            for (int tt = 0; tt < 8; ++tt) { const int t = 16 * tt + fr;
                f32x4 acc = {0.f, 0.f, 0.f, 0.f};
#pragma unroll
                for (int kk = 0; kk < 5; ++kk) acc = MFMA16(wf[j][kk], *(const LAS bf16x8*)(CA + t * CAP + 32 * kk + 8 * fq), acc);
                v2u w; w.x = pk2(acc[0], acc[1]); w.y = pk2(acc[2], acc[3]);
                if (!isk) *(v2u*)(F.QB + (row0 + t) * DB + h * 160 + e0) = w;
                else { *(v2u*)(F.KB + (row0 + t) * DB + h * 160 + e0) = w; const float wk = GA[t];
                       v2u ws; ws.x = pk2(acc[0] * wk, acc[1] * wk); ws.y = pk2(acc[2] * wk, acc[3] * wk); *(LAS v2u*)(KS + t * CAP + e0) = ws; } } } }
    }
    __syncthreads();
    for (int tix = F.wave; tix < 110; tix += 8) { const int vt = tix / 10, et = tix - vt * 10;
        f32x4 acc = {0.f, 0.f, 0.f, 0.f};
        const LAS bf16* ap = VT + (8 * fq + (fr >> 2)) * VTP + vt * 16 + 4 * (fr & 3);
        const LAS bf16* bp = KS + (8 * fq + (fr >> 2)) * CAP + et * 16 + 4 * (fr & 3);
#pragma unroll
        for (int ks = 0; ks < 4; ++ks) { const bf16x8 a = cat8(tr_read(ap + 32 * ks * VTP), tr_read(ap + (32 * ks + 4) * VTP));
                                         const bf16x8 bq = cat8(tr_read(bp + 32 * ks * CAP), tr_read(bp + (32 * ks + 4) * CAP)); acc = MFMA16(a, bq, acc); }
        float* dp = F.DC + ((size_t)item * 161 + vt * 16 + 4 * fq) * 160 + et * 16 + fr;
#pragma unroll
        for (int r = 0; r < 4; ++r) if (vt * 16 + 4 * fq + r <= 160) dp[r * 160] = acc[r];
    }
}
__device__ __forceinline__ void mlstm_scan(Frame& F, int rank, int nwg) {
    LAS float* SA = (LAS float*)F.lds; LAS float* SB = SA + 512; LAS float* SM = SA + 1024;
    __syncthreads();
    for (int idx = F.tid; idx < 512; idx += 512) { SA[idx] = F.BT[idx]; SB[idx] = F.ML[idx]; }
    __syncthreads();
    if (F.tid < 8) { const int chain = F.tid; float m = 0.f;
        for (int c = 0; c < 64; ++c) { const float bt = SA[chain * 64 + c], ml = SB[chain * 64 + c], mn = fmaxf(bt + m, ml);
            SM[chain * 64 + c] = m; SA[chain * 64 + c] = expf(bt + m - mn); SB[chain * 64 + c] = expf(ml - mn); m = mn; }
        SM[512 + chain] = m; }
    __syncthreads();
    if (rank == 0) { F.MS[F.tid] = SM[F.tid]; if (F.tid < 8) F.out[O_PM + F.tid] = SM[512 + F.tid]; }
    const int gt = rank * 512 + F.tid, NT = nwg * 512;
    for (int ec = gt; ec < 8 * 25760; ec += NT) { const int chain = ec / 25760, el = ec - chain * 25760;
        float C = 0.f;
        const float* dc = F.DC + (size_t)chain * 64 * 25760 + el; bf16* cs = F.CS + (size_t)chain * 64 * 28160 + el;
        for (int c0 = 0; c0 < 64; c0 += 16) { float d[16];
#pragma unroll
            for (int j = 0; j < 16; ++j) d[j] = __builtin_nontemporal_load(dc + (size_t)(c0 + j) * 25760);
#pragma unroll
            for (int j = 0; j < 16; ++j) { cs[(size_t)(c0 + j) * 28160] = (bf16)(pk2(C, 0.f) & 0xffffu); C = SA[chain * 64 + c0 + j] * C + SB[chain * 64 + c0 + j] * d[j]; } }
        if (el < 25600) F.out[O_PC + (size_t)chain * 25600 + el] = C; else F.out[O_PN + (size_t)chain * 160 + (el - 25600)] = C;
    }
    __syncthreads();
}
__device__ __forceinline__ void mlstm_stageC_item(Frame& F, int item, bool flip) {
    int lane = F.lane; asm volatile("" : "+v"(lane));
    const int bh = item >> 6, c = item & 63, b = bh >> 2, h = bh & 3, fr = lane & 15, fq = lane >> 4, tid = lane + 64 * F.wave;
    const size_t row0 = (size_t)b * SEQ + (size_t)c * 128;
    LAS bf16* VT = (LAS bf16*)(F.lds + MC_VT);
    LAS float* GU = (LAS float*)(F.lds + MC_GA); LAS float* GM = GU + 128; LAS float* GW = GU + 256; LAS float* GE = GU + 384;
    __syncthreads();
    if (F.wave == 0) {
        const float gb_i = F.in[I_GB][h], gb_f = F.in[I_GB][4 + h], mprev = F.MS[item];
        const float* g0 = F.Gt + (row0 + 2 * lane) * 8;
        const float gi0 = g0[h] + gb_i, gf0 = g0[4 + h] + gb_f, gi1 = g0[8 + h] + gb_i, gf1 = g0[12 + h] + gb_f;
        const float lf0 = log_sigmoid(gf0), lf1 = log_sigmoid(gf1), pair = lf0 + lf1;
        float incl = pair;
#pragma unroll
        for (int o = 1; o < 64; o <<= 1) { const float t = __shfl_up(incl, o); if (lane >= o) incl += t; }
        const float a0 = (incl - pair) + lf0, a1 = incl;
        const float u0 = gi0 - a0, u1 = gi1 - a1;
        float pm = fmaxf(u0, u1);
#pragma unroll
        for (int o = 1; o < 64; o <<= 1) { const float t = __shfl_up(pm, o); if (lane >= o) pm = fmaxf(pm, t); }
        float pe = __shfl_up(pm, 1); if (lane == 0) pe = -1e30f;
        const float M0 = fmaxf(mprev, fmaxf(pe, u0)), M1 = fmaxf(mprev, pm);
        GU[2 * lane] = u0; GU[2 * lane + 1] = u1; GM[2 * lane] = M0; GM[2 * lane + 1] = M1;
        GW[2 * lane] = expf(mprev - M0); GW[2 * lane + 1] = expf(mprev - M1);
        GE[2 * lane] = expf(-(a0 + M0)); GE[2 * lane + 1] = expf(-(a1 + M1));
    }
    {
        v4u xv[5];
#pragma unroll
        for (int j = 0; j < 5; ++j) { const int idx = tid + 512 * j, t = idx / 20, cg = idx - t * 20; xv[j] = *(const v4u*)(F.Z + (row0 + t) * ZP + ZX + h * 160 + cg * 8); }
#pragma unroll
        for (int j = 0; j < 5; ++j) { const int idx = tid + 512 * j, t = idx / 20, cg = idx - t * 20; *(LAS v4u*)(VT + t * VTP + cg * 8) = xv[j]; }
    }
    mlstm_vt_ones(F, VT);
    __syncthreads();
    const int tw = flip ? 7 - F.wave : F.wave, t0 = 16 * tw, tq = t0 + fr;
    const size_t row = row0 + tq;
    bf16x8 qf[5];
#pragma unroll
    for (int kk = 0; kk < 5; ++kk) qf[kk] = *(const bf16x8*)(F.QB + row * DB + h * 160 + 32 * kk + 8 * fq);
    f32x4 acc[11];
    const float wst = GW[tq], Mt = GM[tq], en = GE[tq];
    {
        const bf16* cs = F.CS + (size_t)item * 28160 + (size_t)fr * 160 + 8 * fq;
#pragma unroll
        for (int vt = 0; vt < 11; ++vt) { f32x4 a = {0.f, 0.f, 0.f, 0.f};
#pragma unroll
            for (int kk = 0; kk < 5; ++kk) a = MFMA16(*(const bf16x8*)(cs + vt * 16 * 160 + 32 * kk), qf[kk], a);
            acc[vt] = a * wst; }
    }
    const int npair = (tw >> 1) + 1;
    const bf16* kbase = F.KB + (row0 + fr) * DB + h * 160 + 8 * fq;
    bf16x8 ka[5], kb[5];
#pragma unroll
    for (int kk = 0; kk < 5; ++kk) { ka[kk] = *(const bf16x8*)(kbase + 32 * kk); kb[kk] = *(const bf16x8*)(kbase + (size_t)16 * DB + 32 * kk); }
    for (int i = 0; i < npair; ++i) {
        bf16x8 na[5], nb[5];
        const bool more = i + 1 < npair;
        if (more) {
#pragma unroll
            for (int kk = 0; kk < 5; ++kk) { na[kk] = *(const bf16x8*)(kbase + (size_t)(32 * (i + 1)) * DB + 32 * kk); nb[kk] = *(const bf16x8*)(kbase + (size_t)(32 * (i + 1) + 16) * DB + 32 * kk); } }
        f32x4 sa = {0.f, 0.f, 0.f, 0.f}, sb = sa;
#pragma unroll
        for (int kk = 0; kk < 5; ++kk) { sa = MFMA16(ka[kk], qf[kk], sa); sb = MFMA16(kb[kk], qf[kk], sb); }
        const f32x4 ua = *(const LAS f32x4*)(GU + 32 * i + 4 * fq), ub = *(const LAS f32x4*)(GU + 32 * i + 16 + 4 * fq);
        float pa[4], pb[4];
#pragma unroll
        for (int r = 0; r < 4; ++r) { const int s0 = 32 * i + 4 * fq + r, s1 = s0 + 16;
            pa[r] = s0 <= tq ? sa[r] * __expf(ua[r] - Mt) : 0.f; pb[r] = s1 <= tq ? sb[r] * __expf(ub[r] - Mt) : 0.f; }
        v4u pw; pw.x = pk2(pa[0], pa[1]); pw.y = pk2(pa[2], pa[3]); pw.z = pk2(pb[0], pb[1]); pw.w = pk2(pb[2], pb[3]);
        const bf16x8 pf = __builtin_bit_cast(bf16x8, pw);
        const LAS bf16* vp = VT + (32 * i + 4 * fq + (fr >> 2)) * VTP + 4 * (fr & 3);
#pragma unroll
        for (int vt = 0; vt < 11; ++vt) { const bf16x8 a = cat8(tr_read(vp + vt * 16), tr_read(vp + 16 * VTP + vt * 16)); acc[vt] = MFMA16(a, pf, acc[vt]); }
        if (more) {
#pragma unroll
            for (int kk = 0; kk < 5; ++kk) { ka[kk] = na[kk]; kb[kk] = nb[kk]; } }
    }
    const float den = __shfl(acc[10][0], fr);
    const float inv = 1.0f / fmaxf(fabsf(den), en);
    float ss = 0.f;
#pragma unroll
    for (int vt = 0; vt < 10; ++vt) { acc[vt] = acc[vt] * inv; ss += (acc[vt][0] * acc[vt][0] + acc[vt][1] * acc[vt][1]) + (acc[vt][2] * acc[vt][2] + acc[vt][3] * acc[vt][3]); }
    ss += __shfl_xor(ss, 16); ss += __shfl_xor(ss, 32);
    const float rs = 1.0f / sqrtf(ss * (1.0f / 160.0f) + EPS);
#pragma unroll
    for (int vt = 0; vt < 10; ++vt) { const int ch = h * 160 + vt * 16 + 4 * fq;
        const v2u caw = *(const v2u*)(F.CAB + row * DB + ch);
        const v2u obw = *(const v2u*)(F.Z + row * ZP + ZO + ch);
        const f32x4 ca = {bflo(caw.x), bfhi(caw.x), bflo(caw.y), bfhi(caw.y)};
        const f32x4 ob = {bflo(obw.x), bfhi(obw.x), bflo(obw.y), bfhi(obw.y)};
        const f32x4 mg = *(const f32x4*)(F.in[I_MHG] + ch), sk = *(const f32x4*)(F.in[I_SKIP] + ch);
        float o[4];
#pragma unroll
        for (int e = 0; e < 4; ++e) o[e] = sigmoidf(ob[e]) * (acc[vt][e] * rs * mg[e] + sk[e] * ca[e]);
        v2u w; w.x = pk2(o[0], o[1]); w.y = pk2(o[2], o[3]);
        *(v2u*)(F.CAT + row * DM + DA + ch) = w; }
}
__device__ __forceinline__ void attn_combine_rows2(Frame& F, int rowa, int rowb) {
    const int lane = F.lane;
    float la[2][18], av[2][18];
#pragma unroll
    for (int q = 0; q < 2; ++q) { const int row = q ? rowb : rowa;
#pragma unroll
        for (int g = 0; g < 3; ++g)
#pragma unroll
            for (int h = 0; h < 6; ++h) { la[q][g * 6 + h] = F.LSE[((size_t)g * MP + row) * 6 + h]; av[q][g * 6 + h] = bf2f(F.AO[((size_t)g * MP + row) * DA + h * 64 + lane]); } }
#pragma unroll
    for (int q = 0; q < 2; ++q) { const int row = q ? rowb : rowa;
        float o[6]; float ss = 0.f;
#pragma unroll
        for (int h = 0; h < 6; ++h) { const float l0 = la[q][h], l1 = la[q][6 + h], l2 = la[q][12 + h];
            const float mx = fmaxf(l0, fmaxf(l1, l2)), e0 = __expf(l0 - mx), e1 = __expf(l1 - mx), e2 = __expf(l2 - mx), inv = 1.0f / (e0 + e1 + e2);
            o[h] = (e0 * av[q][h] + e1 * av[q][6 + h] + e2 * av[q][12 + h]) * inv; ss += o[h] * o[h]; }
        ss = wave_sum(ss);
        const float rstd = 1.0f / sqrtf(ss * (1.0f / 384.0f) + EPS);
#pragma unroll
        for (int h = 0; h < 6; ++h) F.CAT[(size_t)row * DM + h * 64 + lane] = (bf16)(pk2(o[h] * rstd * F.in[I_AOG][h * 64 + lane], 0.f) & 0xffffu); }
}
__device__ __forceinline__ void final_norm_row(Frame& F, int m) {
    float* row = m < MP ? F.out + O_YP + (size_t)m * DM : F.out + O_YS + (size_t)(m - MP) * DM;
    f32x4* xr = (f32x4*)row + F.lane; const f32x4* gr = (const f32x4*)F.in[I_FG] + F.lane;
    f32x4 v[4]; float s = 0.f;
    if (m < MP) {
#pragma unroll
        for (int j = 0; j < 4; ++j) v[j] = xr[64 * j];
    } else {
        const f32x4* x1 = (const f32x4*)(F.X1 + (size_t)m * DM) + F.lane;
#pragma unroll
        for (int j = 0; j < 4; ++j) v[j] = x1[64 * j];
#pragma unroll
        for (int ks = 0; ks < 8; ++ks) { const f32x4* sl = (const f32x4*)(F.SLAB + ((size_t)ks * NS + (m - MP)) * DM) + F.lane;
#pragma unroll
            for (int j = 0; j < 4; ++j) v[j] = v[j] + sl[64 * j]; }
    }
#pragma unroll
    for (int j = 0; j < 4; ++j) s += (v[j].x * v[j].x + v[j].y * v[j].y) + (v[j].z * v[j].z + v[j].w * v[j].w);
    const float rstd = 1.0f / sqrtf(wave_sum(s) * (1.f / DM) + EPS);
#pragma unroll
    for (int j = 0; j < 4; ++j) xr[64 * j] = v[j] * rstd * gr[64 * j];
}

struct Args { const float* in[24]; float* out; unsigned char* ws; int ph_lo, ph_hi, li, pad; };
__global__ void __launch_bounds__(NWAVES * 64, 2) mega_fwd(Args args) {
    extern __shared__ __attribute__((aligned(16))) unsigned char lds[];
    Frame F;
    F.lds = (LAS unsigned char*)lds;
    F.MISC = (volatile LAS unsigned*)(F.lds + MISC_OFF);
    F.tid = threadIdx.x; F.lane = F.tid & 63; F.wave = __builtin_amdgcn_readfirstlane(F.tid >> 6);
    F.G = gridDim.x; { const int bx = blockIdx.x; F.vcu = (F.G % 8 == 0) ? (bx % 8) * (F.G / 8) + bx / 8 : bx; }
    unsigned char* ws = args.ws; F.ws = ws; F.out = args.out;
#pragma unroll
    for (int i = 0; i < 24; ++i) F.in[i] = args.in[i];
    F.ctl = (gu32*)(ws + WS_CTL);
    F.WIN = (bf16*)(ws + WS_WIN); F.WOUT = (bf16*)(ws + WS_WOUT); F.W1 = (bf16*)(ws + WS_W1); F.W2 = (bf16*)(ws + WS_W2); F.WQ = (bf16*)(ws + WS_WQ); F.WK = (bf16*)(ws + WS_WK);
    F.XN = (bf16*)(ws + WS_XN); F.Z = (bf16*)(ws + WS_Z); F.AO = (bf16*)(ws + WS_AO); F.CS = (bf16*)(ws + WS_CS); F.CAT = (bf16*)(ws + WS_CAT); F.X1B = (bf16*)(ws + WS_X1B); F.HFF = (bf16*)(ws + WS_HFF); F.QB = (bf16*)(ws + WS_QB); F.KB = (bf16*)(ws + WS_KB); F.CAB = (bf16*)(ws + WS_CAB);
    F.Gt = (float*)(ws + WS_G); F.SS1 = (float*)(ws + WS_SS1); F.SS2 = (float*)(ws + WS_SS2); F.ML = (float*)(ws + WS_ML); F.BT = (float*)(ws + WS_BT); F.MS = (float*)(ws + WS_MS);
    F.LSE = (float*)(ws + WS_LSE); F.DC = (float*)(ws + WS_DC); F.X1 = (float*)(ws + WS_X1); F.SLAB = (float*)(ws + WS_SLAB);
    for (int u = F.tid; u < (LDS_BYTES - LDSCTL_OFF) / 4; u += NWAVES * 64) ((LAS unsigned*)(F.lds + LDSCTL_OFF))[u] = 0u;
    __syncthreads();
    XcdBarrier bar; bar.bar = (unsigned*)(F.ctl + CW_BAR); bar.x = 0; bar.st = nullptr;
    if (N_LAUNCHES != PER_PHASE) bar = xcd_barrier_post((unsigned*)(F.ctl + CW_BAR), F.MISC + 8);
#define GRID_BAR() do { if (N_LAUNCHES != PER_PHASE) { if (STEAL) xcd_barrier_steal(bar, F); else xcd_barrier(bar); } } while (0)
    int& F_tid_ref = F.tid; int& F_lane_ref = F.lane;
    const int lo = args.ph_lo, hi = args.ph_hi;
#define IN(k) (lo <= (k) && (k) < hi)
#define BOTH(k) (IN(k) && IN((k) + 1))
    const int gw = F.vcu * NWAVES + F.wave, NGW = F.G * NWAVES;

    if (IN(0)) PH(0) { p0_prologue(F); if (BOTH(0)) GRID_BAR(); }

    if (IN(1)) PH(1) {
        const int xl = (int)blockIdx.x & 7, slot = (int)blockIdx.x >> 3;
        constexpr int P1_SLOTS = 27;
        if (slot < P1_SLOTS) {
            pg8::Gemm g{F.XN, F.WIN, MP, ZP, DM}; pg8::StaticOrder S; S.init(MP, ZP, 8 * P1_SLOTS, slot * 8 + xl);
            pg8::EpiZ E{F.Z, F.Gt};
            REP(3) pg8::gemm_phase<pg8::EpiZ, pg8::StaticOrder, true, true>(F.lds, g, S, E);
        } else {
            const int cw = (slot - P1_SLOTS) * 8 + xl;
            SEpiZ SE{F.Z, F.Gt};
            for (int u = cw; u < 80; u += 8 * (32 - P1_SLOTS)) small_gemm<2, SEpiZ>(F, F.XN + (size_t)MP * DM, F.WIN, DM, 0, DM, 32 * u, SE);
        }
        if (BOTH(1)) GRID_BAR();
    }

    if (IN(2)) PH(2) {
        __syncthreads();
        LAS float* biasT = (LAS float*)(F.lds + P2_BIAS_OFF);
        build_bias_table(F, biasT);
        __syncthreads();
        { const int gt = F.vcu * 512 + F.tid, NT = F.G * 512;
          for (int idx = gt; idx < NBATCH * 2048 * (2 * DA / 8); idx += NT) { const int cg = idx % 96, rr = idx / 96, b = rr / 2048, t = rr % 2048;
              const v4u w = *(const v4u*)(F.Z + ((size_t)b * SEQ + (SEQ - 2048) + t) * ZP + ZK + cg * 8);
              const int col = cg * 8; float* dst = col < DA ? F.out + O_PWK + ((size_t)b * 2048 + t) * DA + col : F.out + O_PWV + ((size_t)b * 2048 + t) * DA + (col - DA);
              *(f32x4*)dst = (f32x4){bflo(w.x), bfhi(w.x), bflo(w.y), bfhi(w.y)}; *(f32x4*)(dst + 4) = (f32x4){bflo(w.z), bfhi(w.z), bflo(w.w), bfhi(w.w)}; }
          for (int idx = gt; idx < NBATCH * 3 * DB; idx += NT) { const int b = idx / (3 * DB), rr = (idx % (3 * DB)) / DB, ch = idx % DB;
              F.out[O_PCONV + idx] = bf2f(F.Z[((size_t)b * SEQ + (SEQ - 3) + rr) * ZP + ZX + ch]); } }
        { LAS float* obuf = (LAS float*)(F.lds + P2_SA_OFF);
          REP(4) for (int b = F.vcu; b < NS; b += F.G) attn_sample_item(F, b, biasT, obuf); }
        __syncthreads();
        { const bool light = F.vcu < NS; const int nit = light ? 3 : 6, base = light ? F.vcu * 3 : 3 * NS + (F.vcu - NS) * 6;
          REP(5) for (int j = 0; j < nit; ++j) attn_prompt_wgitem(F, base + j, biasT); }
        __syncthreads();
        { LAS float* sb = (LAS float*)(F.lds);
          REP(6) for (int it = F.vcu; it < NS * HB; it += F.G) mlstm_sample_item(F, it, sb); }
        __syncthreads();
        REP(7) for (int it = F.vcu; it < 512; it += F.G) mlstm_stageA_item(F, it);
        if (BOTH(2)) GRID_BAR();
    }

    if (IN(3)) PH(3) { if (F.vcu < 16) { SEpiX1 SE{F.in[I_XS], F.X1, F.X1B, F.SS1}; small_gemm<4, SEpiX1>(F, F.CAT + (size_t)MP * DM, F.WOUT, DM, 0, DM, 64 * F.vcu, SE); }
        else { REP(8) mlstm_scan(F, F.vcu - 16, F.G - 16); }
        if (BOTH(3)) GRID_BAR(); }

    if (IN(4)) PH(4) {
        REP(9) { bool flip = false; for (int it = F.vcu; it < 512; it += F.G) { mlstm_stageC_item(F, it, flip); flip = !flip; } }
        if (F.vcu < 128) { SEpiFF1 SE{F.HFF, F.SS1}; small_gemm<2, SEpiFF1>(F, F.X1B + (size_t)MP * DM, F.W1, DM, 0, DM, 32 * F.vcu, SE); }
        else { const int w2 = gw - 128 * NWAVES; REP(10) for (int m = 2 * w2; m < MP; m += 2 * 128 * NWAVES) attn_combine_rows2(F, m, m + 1); }
        if (BOTH(4)) GRID_BAR();
    }

    if (IN(5)) PH(5) {
        __syncthreads();
        pg8::Gemm g{F.CAT, F.WOUT, MP, DM, DM}; pg8::StaticOrder S; S.init(MP, DM, F.G, (int)blockIdx.x);
        pg8::EpiX1 E{F.in[I_XP], F.in[I_XS], F.X1, F.X1B, F.SS1};
        REP(11) pg8::gemm_phase<pg8::EpiX1, pg8::StaticOrder, true, true>(F.lds, g, S, E);
        { const int u = F.vcu & 31, ks = F.vcu >> 5; if (ks < 8) { SEpiSlab SE{F.SLAB + (size_t)ks * NS * DM}; small_gemm<2, SEpiSlab>(F, F.HFF + (size_t)MP * DFF, F.W2, DFF, 512 * ks, 512 * ks + 512, 32 * u, SE); } }
        if (BOTH(5)) GRID_BAR();
    }
    if (IN(6)) PH(6) {
        const int xl = (int)blockIdx.x & 7, slot = (int)blockIdx.x >> 3;
        constexpr int P6_SLOTS = 26;
        if (slot < P6_SLOTS) {
            pg8::Gemm g{F.X1B, F.W1, MP, DFF, DM}; pg8::StaticOrder S; S.init(MP, DFF, 8 * P6_SLOTS, slot * 8 + xl);
            pg8::EpiFF1 E{F.HFF, F.SS1};
            pg8::gemm_phase<pg8::EpiFF1, pg8::StaticOrder, true, true>(F.lds, g, S, E);
        }
        if (BOTH(6)) GRID_BAR();
    }
    if (IN(7)) PH(7) {
        pg8::Gemm g{F.HFF, F.W2, MP, DM, DFF}; pg8::StaticOrder S; S.init(MP, DM, F.G, (int)blockIdx.x);
        pg8::EpiX2 E{F.X1, F.out + O_YP, F.out + O_YS, F.SS2};
        REP(13) pg8::gemm_phase<pg8::EpiX2, pg8::StaticOrder, true, true>(F.lds, g, S, E);
        if (BOTH(7)) GRID_BAR();
    }
    if (IN(8)) { REP(14) for (int m = gw; m < MT; m += NGW) final_norm_row(F, m); REP(15) copy_drain(F); }
#undef IN
#undef BOTH
}

extern "C" void kernel_launch(void* const* d_in, const int* in_sizes, int n_in, void* d_out, int out_size, void* d_ws, size_t ws_size, hipStream_t stream) {
    static int grid = 0;
    if (grid == 0) {
        if (n_in != 24 || (size_t)out_size != O_END || ws_size < WS_END) { fprintf(stderr, "kernel_launch: unexpected sizes n_in %d out %d ws %zu\n", n_in, out_size, ws_size); grid = -1; return; }
        int dev = 0, cus = 0, per_cu = 0;
        if (hipGetDevice(&dev) != hipSuccess || hipDeviceGetAttribute(&cus, hipDeviceAttributeMultiprocessorCount, dev) != hipSuccess) { grid = -1; return; }
        if (hipFuncSetAttribute((const void*)mega_fwd, hipFuncAttributeMaxDynamicSharedMemorySize, LDS_BYTES) != hipSuccess) { fprintf(stderr, "kernel_launch: hipFuncSetAttribute failed\n"); grid = -1; return; }
        if (hipOccupancyMaxActiveBlocksPerMultiprocessor(&per_cu, (const void*)mega_fwd, NWAVES * 64, LDS_BYTES) != hipSuccess || per_cu < 1) { fprintf(stderr, "kernel_launch: occupancy query says %d blocks per CU\n", per_cu); (void)hipGetLastError(); grid = -1; return; }
        grid = cus;
    }
    if (grid < 0) return;
    (void)hipMemsetAsync((char*)d_ws + WS_CTL, 0, CTL_ZERO_BYTES, stream);
    Args a{};
    for (int i = 0; i < 24; ++i) a.in[i] = (const float*)d_in[i];
    a.out = (float*)d_out; a.ws = (unsigned char*)d_ws;
    if (N_LAUNCHES == PER_PHASE) {
        for (int li = 0; li < PER_PHASE; ++li) { a.ph_lo = li; a.ph_hi = li + 1; a.li = li; hipLaunchKernelGGL(mega_fwd, dim3(grid), dim3(NWAVES * 64), LDS_BYTES, stream, a); }
    } else {
        a.ph_lo = 0; a.ph_hi = PER_PHASE; a.li = 0;
        hipLaunchKernelGGL(mega_fwd, dim3(grid), dim3(NWAVES * 64), LDS_BYTES, stream, a);
    }
}
```
